# Optimizing an MI355X kernel written in HIP

```python
import jax, jax.numpy as jnp
from jax import lax
import numpy as np

D_MODEL = 1024
BATCH = 16
SEQ = 2048
DEPTH = 2
DEC_BATCH = 32
DEC_SEQ = 32
PAST_LEN = 2048

CHUNK = 64
N_EVEN = (DEPTH + 1) // 2
N_ODD = DEPTH // 2
EPS = 1e-6
FFN_SCALE = 0.5
D_FF = 2816
H_A = 8
DK_A = D_MODEL // H_A
DV_A = D_MODEL // H_A
HGRN_BLOCK = 16
H_B = 8
DH_B = D_MODEL // H_B
Q_BLOCK = 128
GMLP_LEN = 128
D_C = 2 * D_MODEL
G_C = 8
DG_C = D_C // G_C
EVEN_SIZES = (H_A * DK_A, H_A * DK_A, H_A * DV_A, H_A * DV_A, H_B * DH_B, H_B * DH_B, H_B * DH_B)
D_IN_EVEN = 2 * H_A * DK_A + 2 * H_A * DV_A + 3 * H_B * DH_B
D_MIX_EVEN = H_A * DV_A + H_B * DH_B

kernel_name = 'hybrid_hgrn2_stickbreak_gmlp_stream_step'


def _split_points(sizes):
    pts, acc = [], 0
    for s in sizes[:-1]:
        acc += s
        pts.append(acc)
    return pts


def _rms(x, g):
    xf = x.astype(jnp.float32)
    y = xf * lax.rsqrt(jnp.mean(jnp.square(xf), axis=-1, keepdims=True) + EPS)
    return (y * g.astype(jnp.float32)).astype(x.dtype)


def _layernorm(x, g, b):
    xf = x.astype(jnp.float32)
    xc = xf - jnp.mean(xf, axis=-1, keepdims=True)
    y = xc * lax.rsqrt(jnp.mean(jnp.square(xc), axis=-1, keepdims=True) + EPS)
    return (y * g.astype(jnp.float32) + b.astype(jnp.float32)).astype(x.dtype)


def _swiglu(x, w_gate, w_up, w_down):
    return (jax.nn.silu(x @ w_gate) * (x @ w_up)) @ w_down


def _hgrn_lower_bounds(lb_param):
    p = jax.nn.softmax(lb_param.astype(jnp.float32), axis=0)
    return jnp.cumsum(p, axis=0)[:-1]


def _hgrn2(q, k, v, log_f, s0):
    B, T, H, _ = q.shape
    L = HGRN_BLOCK
    n_blk = -(-T // L)
    pad = n_blk * L - T

    def prep(a):
        a = jnp.pad(a, ((0, 0), (0, pad), (0, 0), (0, 0)))
        return jnp.moveaxis(a.reshape(B, n_blk, L, H, a.shape[-1]), 1, 0)

    causal = jnp.tril(jnp.ones((L, L), dtype=bool))

    def step(S, blk):
        qb, kb, vb, lfb = blk
        c = jnp.cumsum(lfb, axis=1)
        diff = c[:, :, None] - c[:, None, :]
        decay = jnp.exp(jnp.where(causal[None, :, :, None, None], diff, -jnp.inf))
        scores = jnp.einsum('bthc,btshc,bshc->bhts', qb, decay, kb)
        o = jnp.einsum('bhts,bshd->bthd', scores, vb) + jnp.einsum('bthc,bhcd->bthd', qb * jnp.exp(c), S)
        c_last = c[:, -1]
        k_dec = kb * jnp.exp(c_last[:, None] - c)
        S_new = jnp.exp(c_last)[..., None] * S + jnp.einsum('bshc,bshd->bhcd', k_dec, vb)
        return S_new, o

    S_fin, o = lax.scan(step, s0, (prep(q), prep(k), prep(v), prep(log_f)))
    o = jnp.moveaxis(o, 0, 1).reshape(B, n_blk * L, H, v.shape[-1])[:, :T]
    return o, S_fin


def _stick_breaking(q, q_pos, k, v, k_pos):
    z = jnp.einsum('bqhd,bkhd->bhqk', q, k, preferred_element_type=jnp.float32) * (DH_B ** -0.5)
    mask = (k_pos[None, :] < q_pos[:, None])[None, None]
    log_stay = jnp.where(mask, jax.nn.log_sigmoid(-z), 0.0)
    log_pass = lax.cumsum(log_stay, axis=3, reverse=True) - log_stay
    w = jnp.where(mask, jnp.exp(jax.nn.log_sigmoid(z) + log_pass), 0.0)
    return jnp.einsum('bhqk,bkhd->bqhd', w.astype(v.dtype), v, preferred_element_type=jnp.float32)


def _mixer_ab(h, w_in, lb, g_out, g_q, g_k, w_out, s0, k_past, v_past):
    B, T, _ = h.shape
    f32 = jnp.float32
    qa, fa, va, ga, qb, kb, vb = jnp.split(h @ w_in, _split_points(EVEN_SIZES), axis=-1)
    heads_a = lambda a: a.reshape(B, T, H_A, -1)
    f = lb + (1.0 - lb) * jax.nn.sigmoid(fa.astype(f32))
    if s0 is None:
        s0 = jnp.zeros((B, H_A, DK_A, DV_A), f32)
    o_a, s_new = _hgrn2(heads_a(jax.nn.silu(qa).astype(f32)), heads_a(1.0 - f),
                        heads_a(va.astype(f32)), heads_a(jnp.log(f)), s0.astype(f32))
    o_a = _rms(o_a, g_out) * jax.nn.sigmoid(heads_a(ga.astype(f32)))
    qb = _rms(qb.reshape(B, T, H_B, DH_B), g_q)
    kb = _rms(kb.reshape(B, T, H_B, DH_B), g_k)
    vb = vb.reshape(B, T, H_B, DH_B)
    if k_past is None:
        nq = T // Q_BLOCK
        q_blocks = jnp.moveaxis(qb.reshape(B, nq, Q_BLOCK, H_B, DH_B), 1, 0)
        q_pos = jnp.arange(T).reshape(nq, Q_BLOCK)
        k_pos = jnp.arange(T)
        o_b = lax.map(lambda a: _stick_breaking(a[0], a[1], kb, vb, k_pos), (q_blocks, q_pos))
        o_b = jnp.moveaxis(o_b, 0, 1).reshape(B, T, H_B, DH_B)
    else:
        P = k_past.shape[1]
        k_all = jnp.concatenate([k_past.astype(kb.dtype), kb], axis=1)
        v_all = jnp.concatenate([v_past.astype(vb.dtype), vb], axis=1)
        o_b = _stick_breaking(qb, P + jnp.arange(T), k_all, v_all, jnp.arange(P + T))
    mix = jnp.concatenate([o_a.reshape(B, T, -1).astype(h.dtype), o_b.reshape(B, T, -1).astype(h.dtype)], axis=-1)
    return mix @ w_out, s_new.astype(h.dtype), kb, vb


def _mixer_c(h, w_in, ln_g, ln_b, w_s, b_s, w_out):
    B, T, _ = h.shape
    u, v = jnp.split(jax.nn.gelu(h @ w_in), 2, axis=-1)
    v = _layernorm(v, ln_g, ln_b)
    L = min(T, GMLP_LEN)
    n = T // L
    pos = jnp.arange(L)
    mask = (pos[None, :] // CHUNK) <= (pos[:, None] // CHUNK)
    ws = jnp.where(mask[None], w_s[:, :L, :L], 0.0).astype(v.dtype)
    vg = v.reshape(B, n, L, G_C, DG_C)
    mixed = jnp.einsum('gij,bnjgc->bnigc', ws, vg) + b_s[:, :L].T[None, None, :, :, None].astype(v.dtype)
    return (u * mixed.reshape(B, T, D_C)) @ w_out, v


def _trunk(x, p, hgrn_state, sb_k, sb_v):
    lbs = _hgrn_lower_bounds(p['ab_lb'])
    new_k, new_v, new_s, new_cv = [], [], [], []
    for l in range(DEPTH):
        x = x + FFN_SCALE * _swiglu(_rms(x, p['ffn1_norm'][l]), p['ffn1_w_gate'][l], p['ffn1_w_up'][l], p['ffn1_w_down'][l])
        h = _rms(x, p['mix_norm'][l])
        if l % 2 == 0:
            e = l // 2
            y, s, k, v = _mixer_ab(h, p['ab_w_in'][e], lbs[e], p['ab_g_out'][e], p['ab_g_q'][e], p['ab_g_k'][e],
                                   p['ab_w_out'][e],
                                   None if hgrn_state is None else hgrn_state[e],
                                   None if sb_k is None else sb_k[e],
                                   None if sb_v is None else sb_v[e])
            new_s.append(s)
            new_k.append(k)
            new_v.append(v)
        else:
            o = l // 2
            y, cv = _mixer_c(h, p['c_w_in'][o], p['c_ln_g'][o], p['c_ln_b'][o], p['c_w_s'][o], p['c_b_s'][o], p['c_w_out'][o])
            new_cv.append(cv)
        x = x + y
        x = x + FFN_SCALE * _swiglu(_rms(x, p['ffn2_norm'][l]), p['ffn2_w_gate'][l], p['ffn2_w_up'][l], p['ffn2_w_down'][l])
    return x, new_k, new_v, new_s, new_cv


def setup_inputs(seed: int = 0) -> dict:
    key = jax.random.key(seed)
    ks = iter(jax.random.split(key, 40))
    nrm = lambda shape, scale: jax.random.normal(next(ks), shape, jnp.float32) * scale
    gain = lambda shape: 1.0 + nrm(shape, 0.02)
    return {
        'x_prompt': nrm((BATCH, SEQ, D_MODEL), 1.0),
        'x_sample': nrm((DEC_BATCH, DEC_SEQ, D_MODEL), 1.0),
        'cache_sb_k': nrm((N_EVEN, DEC_BATCH, PAST_LEN, H_B, DH_B), 1.0),
        'cache_sb_v': nrm((N_EVEN, DEC_BATCH, PAST_LEN, H_B, DH_B), 1.0),
        'state_hgrn': nrm((N_EVEN, DEC_BATCH, H_A, DK_A, DV_A), 0.5),
        'ffn1_norm': gain((DEPTH, D_MODEL)),
        'ffn1_w_gate': nrm((DEPTH, D_MODEL, D_FF), D_MODEL ** -0.5),
        'ffn1_w_up': nrm((DEPTH, D_MODEL, D_FF), D_MODEL ** -0.5),
        'ffn1_w_down': nrm((DEPTH, D_FF, D_MODEL), D_FF ** -0.5),
        'mix_norm': gain((DEPTH, D_MODEL)),
        'ffn2_norm': gain((DEPTH, D_MODEL)),
        'ffn2_w_gate': nrm((DEPTH, D_MODEL, D_FF), D_MODEL ** -0.5),
        'ffn2_w_up': nrm((DEPTH, D_MODEL, D_FF), D_MODEL ** -0.5),
        'ffn2_w_down': nrm((DEPTH, D_FF, D_MODEL), D_FF ** -0.5),
        'ab_w_in': nrm((N_EVEN, D_MODEL, D_IN_EVEN), D_MODEL ** -0.5),
        'ab_lb': nrm((N_EVEN + 1, H_A * DK_A), 0.1),
        'ab_g_out': gain((N_EVEN, H_A, DV_A)),
        'ab_g_q': gain((N_EVEN, DH_B)),
        'ab_g_k': gain((N_EVEN, DH_B)),
        'ab_w_out': nrm((N_EVEN, D_MIX_EVEN, D_MODEL), D_MIX_EVEN ** -0.5),
        'c_w_in': nrm((N_ODD, D_MODEL, 2 * D_C), D_MODEL ** -0.5),
        'c_ln_g': gain((N_ODD, D_C)),
        'c_ln_b': nrm((N_ODD, D_C), 0.02),
        'c_w_s': nrm((N_ODD, G_C, GMLP_LEN, GMLP_LEN), GMLP_LEN ** -0.5),
        'c_b_s': 1.0 + nrm((N_ODD, G_C, GMLP_LEN), 0.1),
        'c_w_out': nrm((N_ODD, D_C, D_MODEL), D_C ** -0.5),
    }


def reference(x_prompt, x_sample, cache_sb_k, cache_sb_v, state_hgrn, ffn1_norm, ffn1_w_gate, ffn1_w_up,
              ffn1_w_down, mix_norm, ffn2_norm, ffn2_w_gate, ffn2_w_up, ffn2_w_down, ab_w_in, ab_lb, ab_g_out,
              ab_g_q, ab_g_k, ab_w_out, c_w_in, c_ln_g, c_ln_b, c_w_s, c_b_s, c_w_out):
    p = {'ffn1_norm': ffn1_norm, 'ffn1_w_gate': ffn1_w_gate, 'ffn1_w_up': ffn1_w_up, 'ffn1_w_down': ffn1_w_down,
         'mix_norm': mix_norm, 'ffn2_norm': ffn2_norm, 'ffn2_w_gate': ffn2_w_gate, 'ffn2_w_up': ffn2_w_up,
         'ffn2_w_down': ffn2_w_down, 'ab_w_in': ab_w_in, 'ab_lb': ab_lb, 'ab_g_out': ab_g_out, 'ab_g_q': ab_g_q,
         'ab_g_k': ab_g_k, 'ab_w_out': ab_w_out, 'c_w_in': c_w_in, 'c_ln_g': c_ln_g, 'c_ln_b': c_ln_b,
         'c_w_s': c_w_s, 'c_b_s': c_b_s, 'c_w_out': c_w_out}
    y_prompt, pk, pv, ps, _ = _trunk(x_prompt, p, None, None, None)
    y_sample, sk, sv, ss, scv = _trunk(x_sample, p, state_hgrn, cache_sb_k, cache_sb_v)
    return (y_prompt, y_sample, jnp.stack(pk), jnp.stack(pv), jnp.stack(ps),
            jnp.stack(sk), jnp.stack(sv), jnp.stack(ss), jnp.stack(scv))
```

```cpp
#include <hip/hip_runtime.h>
#include <hip/hip_cooperative_groups.h>
#include <cstdio>
#include <cstdint>
namespace cg = cooperative_groups;

#define DI __device__ __forceinline__
#define LAS __attribute__((address_space(3)))
typedef unsigned short bf16_t;
typedef short bf16x8 __attribute__((ext_vector_type(8)));
typedef short s16x4 __attribute__((ext_vector_type(4)));
typedef float f32x4 __attribute__((ext_vector_type(4)));
typedef float f32x16 __attribute__((ext_vector_type(16)));
typedef unsigned u32x4 __attribute__((ext_vector_type(4)));
typedef unsigned u32x2 __attribute__((ext_vector_type(2)));
typedef float f32x2_t __attribute__((ext_vector_type(2)));
typedef __bf16 bf16x2_t __attribute__((ext_vector_type(2)));
typedef short v4i16_t __attribute__((ext_vector_type(4)));

constexpr int D = 1024, DFF = 2816, MP = 32768, MS = 1024, M = MP + MS, SEQ = 2048, TS = 32;
constexpr float EPS = 1e-6f;
constexpr size_t OUT_Y = 0, OUT_KP = 34603008, OUT_VP = 68157440, OUT_HP = 101711872, OUT_KS = 103809024, OUT_VS = 104857600,
                 OUT_HS = 105906176, OUT_GV = 110100480, OUT_TOTAL = 112197632;
constexpr size_t MiB = 1u << 20;
constexpr size_t SZB = (size_t)M * 1024 * 2;
constexpr size_t WS_WGU = 0;
constexpr size_t WS_WD = 44 * MiB;
constexpr size_t WS_WIN = 66 * MiB;
constexpr size_t WS_WOUT = 80 * MiB;
constexpr size_t WS_WCIN = 84 * MiB;
constexpr size_t WS_WCOUT = 92 * MiB;
constexpr size_t WS_SS = 96 * MiB;
constexpr size_t WS_VST = WS_SS + (size_t)6 * M * 4;
constexpr size_t WS_BAR = 97 * MiB + 512 * 1024;
constexpr size_t WS_XB = 98 * MiB;
constexpr size_t WS_R = 164 * MiB;
constexpr size_t WS_GU = WS_R;
constexpr size_t WS_QT = WS_R, WS_KT = WS_QT + SZB, WS_KH = WS_KT + SZB, WS_DEC = WS_KH + SZB;
constexpr size_t WS_VA = WS_DEC + 5 * MiB, WS_GA = WS_VA + SZB, WS_QB = WS_GA + SZB, WS_KB = WS_QB + SZB, WS_VB = WS_KB + SZB;
constexpr size_t WS_MIX = WS_VB + SZB;
constexpr size_t WS_U = WS_R, WS_V = WS_U + 2 * SZB, WS_GATED = WS_V + 2 * SZB;
constexpr size_t WS_END = WS_MIX + 2 * SZB;
static_assert(WS_VST + (size_t)M * 8 <= WS_XB && WS_GATED + 2 * SZB <= WS_END && WS_GU + (size_t)M * DFF * 2 <= WS_END, "ws map");

constexpr int LDS_BYTES = 147456;

struct Params { const float* in[26]; float* out; unsigned char* ws; };

DI unsigned cvtpk(float lo, float hi) { f32x2_t v = {lo, hi}; bf16x2_t b = __builtin_convertvector(v, bf16x2_t); return __builtin_bit_cast(unsigned, b); }
DI float bflo(unsigned u) { return __uint_as_float(u << 16); }
DI float bfhi(unsigned u) { return __uint_as_float(u & 0xffff0000u); }
DI float bf2f(bf16_t b) { return __uint_as_float((unsigned)b << 16); }
DI bf16_t f2bf(float f) { return (bf16_t)(cvtpk(f, 0.f) & 0xffffu); }
DI float fsigmoid(float x) { return __fdividef(1.f, 1.f + __expf(-x)); }
DI float fsilu(float x) { return __fdividef(x, 1.f + __expf(-x)); }
DI float fgelu(float x) { const float u2 = 1.5957691216057308f * (x + 0.044715f * x * x * x); return __fdividef(x, 1.f + __expf(-u2)); }
DI int crow(int reg, int h) { return (reg & 3) + 8 * (reg >> 2) + 4 * h; }
DI float wave_sum(float v) {
#pragma unroll
    for (int o = 1; o < 64; o <<= 1) v += __shfl_xor(v, o);
    return v;
}
DI bf16x8 pack8(const f32x16& x, int s) {
    u32x4 p; p.x = cvtpk(x[8 * s], x[8 * s + 1]); p.y = cvtpk(x[8 * s + 2], x[8 * s + 3]); p.z = cvtpk(x[8 * s + 4], x[8 * s + 5]); p.w = cvtpk(x[8 * s + 6], x[8 * s + 7]);
    return __builtin_bit_cast(bf16x8, p);
}
DI bf16x8 pack8f(f32x4 a, f32x4 b) { u32x4 p; p.x = cvtpk(a[0], a[1]); p.y = cvtpk(a[2], a[3]); p.z = cvtpk(b[0], b[1]); p.w = cvtpk(b[2], b[3]); return __builtin_bit_cast(bf16x8, p); }
DI s16x4 vtr(LAS const unsigned char* p) { return __builtin_bit_cast(s16x4, __builtin_amdgcn_ds_read_tr16_b64_v4i16((LAS v4i16_t*)p)); }
DI bf16x8 cat8(s16x4 lo, s16x4 hi) { return __builtin_shufflevector(lo, hi, 0, 1, 2, 3, 4, 5, 6, 7); }
#define FENCE() asm volatile("" ::: "memory")
#define MFMA32(a, b, c) __builtin_amdgcn_mfma_f32_32x32x16_bf16((a), (b), (c), 0, 0, 0)

namespace pg8 {
constexpr int BM = 256, BK = 64, HALF = 128, HTB = HALF * BK * 2, STAGE_BYTES = 8 * HTB, NXCD = 8, WGM = 8;
DI int lds_byte(int r, int c) { const int st = (r >> 4) * 2 + (c >> 5), rr = r & 15, cc = c & 31, ob = rr * 64 + cc * 2; return st * 1024 + (ob ^ (((ob >> 9) & 1) << 5)); }
DI void stage_rc(int b, int& R, int& C) { const int st = b / 1024, sb = b % 1024, swz = sb ^ (((sb >> 9) & 1) << 5); R = (st >> 1) * 16 + swz / 64; C = (st & 1) * 32 + (swz % 64) / 2; }
DI int perm32(int rho) { const int n = rho >> 4, i = rho & 15; return 8 * (i >> 2) + 4 * n + (i & 3); }
struct Unit { int pm, pn; };
struct Gemm { const bf16_t* A; const bf16_t* Bt; int M, N, K; };
struct StaticOrder {
    int nM, nN, nwg, G, c;
    DI void init(int M_, int N_, int G_, int c_) { nM = M_ / BM; nN = N_ / BM; nwg = nM * nN; G = G_; c = c_; }
    DI bool next(int i, Unit& u) const {
        const long L = (long)i * G + c; if (L >= nwg) return false;
        int wgid = (int)L; { const int q = nwg / NXCD, r = nwg % NXCD, xcd = wgid % NXCD, off = wgid / NXCD; wgid = (xcd < r ? xcd * (q + 1) : r * (q + 1) + (xcd - r) * q) + off; }
        const int nig = WGM * nN, gid = wgid / nig, fm = gid * WGM, gsz = (nM - fm) < WGM ? (nM - fm) : WGM;
        u.pm = fm + ((wgid % nig) % gsz); u.pn = (wgid % nig) / gsz; return true;
    }
    DI void a_ready(const Unit&) const {}
    DI void done(const Unit&) const {}
};
template <class Epi, class Sched, bool ALIGN_EPI = false, bool SP2 = false>
DI void gemm_phase(LAS unsigned char* lds, const Gemm g, const Sched& S, const Epi& E) {
    int tid_ = threadIdx.x; asm volatile("" : "+v"(tid_));
    const int tid = tid_, wid = __builtin_amdgcn_readfirstlane(tid >> 6), lane = tid & 63, wr = wid >> 2, wc = wid & 3, fr = lane & 15, fq = lane >> 4;
    const int K = g.K, nt = K / BK;
    unsigned voffA[2], voffB[2];
#pragma unroll
    for (int i = 0; i < 2; ++i) { int R, C; stage_rc(tid * 16 + i * 8192, R, C); const int Rb = Epi::PERM ? ((R & ~31) + perm32(R & 31)) : R;
        voffA[i] = (unsigned)(R * K + C) * 2u; voffB[i] = (unsigned)(Rb * K + C) * 2u; }
    const size_t kstep = (size_t)(BK * 2);
    const size_t hstep = (size_t)HALF * K * 2;
    const size_t tstep = 2 * hstep;
    const unsigned ldsw = (unsigned)wid * 1024u;
    const int aoff = lds_byte(wr * 64 + fr, fq * 8), boff = lds_byte(wc * 32 + fr, fq * 8);
#define PG8_SA(b, h) (((b) * 2 + (h)) * HTB)
#define PG8_SB(b, h) ((4 + (b) * 2 + (h)) * HTB)
#define PG8_STAGE(bufoff, gbase, voff) do { _Pragma("unroll") for (int _i = 0; _i < 2; ++_i) \
        __builtin_amdgcn_global_load_lds((const unsigned*)((const char*)(gbase) + (voff)[_i]), (LAS unsigned*)(lds + (bufoff) + ldsw + _i * 8192), 16, 0, 0); } while (0)
#define PG8_LDA(dst, b, h) do { _Pragma("unroll") for (int m = 0; m < 4; ++m) _Pragma("unroll") for (int k = 0; k < 2; ++k) dst[m][k] = *(const LAS bf16x8*)(lds + PG8_SA(b, h) + aoff + m * 2048 + k * 1024); } while (0)
#define PG8_LDB(dst, b, h) do { _Pragma("unroll") for (int n = 0; n < 2; ++n) _Pragma("unroll") for (int k = 0; k < 2; ++k) dst[n][k] = *(const LAS bf16x8*)(lds + PG8_SB(b, h) + boff + n * 2048 + k * 1024); } while (0)
#define PG8_MMA(ai, bj, At, Bt) do { __builtin_amdgcn_s_setprio(1); _Pragma("unroll") for (int m = 0; m < 4; ++m) _Pragma("unroll") for (int n = 0; n < 2; ++n) _Pragma("unroll") for (int k = 0; k < 2; ++k) \
        acc[ai][bj][m][n] = __builtin_amdgcn_mfma_f32_16x16x32_bf16(Bt[n][k], At[m][k], acc[ai][bj][m][n], 0, 0, 0); __builtin_amdgcn_s_setprio(0); } while (0)
#define PG8_WAIT_V(n) asm volatile("s_waitcnt vmcnt(" #n ")" ::: "memory")
#define PG8_WAIT_L(n) asm volatile("s_waitcnt lgkmcnt(" #n ")" ::: "memory")
#define PG8_BAR __builtin_amdgcn_s_barrier()
#define PG8_SCHED __builtin_amdgcn_sched_barrier(0)
    Unit cur, nxt; int ui = 0;
    if (!S.next(0, cur)) return;
    f32x4 acc[2][2][4][2];
#pragma unroll
    for (int a = 0; a < 2; ++a)
#pragma unroll
        for (int b = 0; b < 2; ++b)
#pragma unroll
            for (int m = 0; m < 4; ++m)
#pragma unroll
                for (int n = 0; n < 2; ++n) acc[a][b][m][n] = (f32x4){0.f, 0.f, 0.f, 0.f};
    bf16x8 At[4][2], B0[2][2], B1[2][2];
    const char* cA = (const char*)g.A + (size_t)cur.pm * tstep; const char* cB = (const char*)g.Bt + (size_t)cur.pn * tstep;
    S.a_ready(cur);
    if constexpr (SP2) {
        PG8_STAGE(PG8_SB(0, 0), cB, voffB); PG8_STAGE(PG8_SB(0, 1), cB + hstep, voffB); PG8_STAGE(PG8_SA(0, 0), cA, voffA); PG8_STAGE(PG8_SA(0, 1), cA + hstep, voffA);
        if (wr == 1) PG8_BAR;
        PG8_WAIT_V(2); PG8_BAR;
        PG8_STAGE(PG8_SB(1, 0), cB + kstep, voffB); PG8_STAGE(PG8_SA(1, 0), cA + kstep, voffA); PG8_STAGE(PG8_SB(1, 1), cB + hstep + kstep, voffB);
        PG8_WAIT_V(6); PG8_BAR;
    } else {
        PG8_STAGE(PG8_SB(0, 0), cB, voffB); PG8_STAGE(PG8_SA(0, 0), cA, voffA); PG8_STAGE(PG8_SB(0, 1), cB + hstep, voffB); PG8_STAGE(PG8_SA(0, 1), cA + hstep, voffA);
        if (wr == 1) PG8_BAR;
        PG8_WAIT_V(4); PG8_BAR;
        PG8_STAGE(PG8_SB(1, 0), cB + kstep, voffB); PG8_STAGE(PG8_SA(1, 0), cA + kstep, voffA); PG8_STAGE(PG8_SB(1, 1), cB + hstep + kstep, voffB);
        PG8_WAIT_V(6); PG8_BAR;
    }
    for (;;) {
        const bool has_next = S.next(ui + 1, nxt);
        const char* nA = has_next ? (const char*)g.A + (size_t)nxt.pm * tstep : cA; const char* nB = has_next ? (const char*)g.Bt + (size_t)nxt.pn * tstep : cB;
        for (int t = 0; t < nt; t += 2) {
            const bool last = (t == nt - 2);
            const char* a1 = cA + (size_t)(t + 1) * kstep;
            const char* a2 = last ? nA : cA + (size_t)(t + 2) * kstep; const char* b2 = last ? nB : cB + (size_t)(t + 2) * kstep;
            const char* a3 = a2 + kstep; const char* b3 = b2 + kstep;
            if (last && has_next) S.a_ready(nxt);
            if constexpr (SP2) {
            PG8_LDB(B0, 0, 0); PG8_LDB(B1, 0, 1); PG8_SCHED; PG8_LDA(At, 0, 0); PG8_STAGE(PG8_SA(1, 1), a1 + hstep, voffA);
            PG8_WAIT_V(8); PG8_WAIT_L(0); PG8_BAR; PG8_MMA(0, 0, At, B0); PG8_MMA(0, 1, At, B1); PG8_BAR; PG8_SCHED;
            PG8_LDA(At, 0, 1); PG8_STAGE(PG8_SB(0, 0), b2, voffB); PG8_STAGE(PG8_SB(0, 1), b2 + hstep, voffB); PG8_STAGE(PG8_SA(0, 0), a2, voffA);
            PG8_WAIT_V(8); PG8_WAIT_L(0); PG8_BAR; PG8_MMA(1, 0, At, B0); PG8_MMA(1, 1, At, B1); PG8_BAR; PG8_SCHED;
            PG8_LDB(B0, 1, 0); PG8_LDB(B1, 1, 1); PG8_SCHED; PG8_LDA(At, 1, 0); PG8_STAGE(PG8_SA(0, 1), a2 + hstep, voffA);
            PG8_WAIT_V(8); PG8_WAIT_L(0); PG8_BAR; PG8_MMA(0, 0, At, B0); PG8_MMA(0, 1, At, B1); PG8_BAR; PG8_SCHED;
            PG8_LDA(At, 1, 1); PG8_STAGE(PG8_SB(1, 0), b3, voffB); PG8_STAGE(PG8_SB(1, 1), b3 + hstep, voffB); PG8_STAGE(PG8_SA(1, 0), a3, voffA);
            PG8_WAIT_V(8); PG8_WAIT_L(0); PG8_BAR; PG8_MMA(1, 0, At, B0); PG8_MMA(1, 1, At, B1); PG8_BAR; PG8_SCHED;
            } else {
            PG8_LDB(B0, 0, 0); PG8_SCHED; PG8_LDA(At, 0, 0); PG8_STAGE(PG8_SA(1, 1), a1 + hstep, voffA);
            PG8_WAIT_L(8); PG8_BAR; PG8_WAIT_L(0); PG8_MMA(0, 0, At, B0); PG8_BAR; PG8_SCHED;
            PG8_LDB(B1, 0, 1); PG8_STAGE(PG8_SB(0, 0), b2, voffB);
            PG8_BAR; PG8_WAIT_L(0); PG8_MMA(0, 1, At, B1); PG8_BAR;
            PG8_LDA(At, 0, 1); PG8_STAGE(PG8_SA(0, 0), a2, voffA);
            PG8_BAR; PG8_WAIT_L(0); PG8_MMA(1, 0, At, B0); PG8_BAR; PG8_SCHED;
            PG8_STAGE(PG8_SB(0, 1), b2 + hstep, voffB);
            PG8_WAIT_V(6); PG8_BAR; PG8_MMA(1, 1, At, B1); PG8_BAR;
            PG8_LDB(B0, 1, 0); PG8_SCHED; PG8_LDA(At, 1, 0); PG8_STAGE(PG8_SA(0, 1), a2 + hstep, voffA);
            PG8_WAIT_L(8); PG8_BAR; PG8_WAIT_L(0); PG8_MMA(0, 0, At, B0); PG8_BAR; PG8_SCHED;
            PG8_LDB(B1, 1, 1); PG8_STAGE(PG8_SB(1, 0), b3, voffB);
            PG8_BAR; PG8_WAIT_L(0); PG8_MMA(0, 1, At, B1); PG8_BAR;
            PG8_LDA(At, 1, 1); PG8_STAGE(PG8_SA(1, 0), a3, voffA);
            PG8_BAR; PG8_WAIT_L(0); PG8_MMA(1, 0, At, B0); PG8_BAR; PG8_SCHED;
            PG8_STAGE(PG8_SB(1, 1), b3 + hstep, voffB);
            PG8_WAIT_V(6); PG8_BAR; PG8_MMA(1, 1, At, B1); PG8_BAR;
            }
        }
        if constexpr (ALIGN_EPI) { if (wr == 0) PG8_BAR; }
        E(acc, cur, wr, wc, fr, fq); S.done(cur);
        if (!has_next) break;
#pragma unroll
        for (int a = 0; a < 2; ++a)
#pragma unroll
            for (int b = 0; b < 2; ++b)
#pragma unroll
                for (int m = 0; m < 4; ++m)
#pragma unroll
                    for (int n = 0; n < 2; ++n) acc[a][b][m][n] = (f32x4){0.f, 0.f, 0.f, 0.f};
        cur = nxt; cA = nA; cB = nB; ++ui;
        if constexpr (ALIGN_EPI) { if (wr == 1) PG8_BAR; }
    }
    PG8_WAIT_V(0);
    if constexpr (!ALIGN_EPI) { if (wr == 0) PG8_BAR; }
    PG8_BAR;
#undef PG8_SA
#undef PG8_SB
#undef PG8_STAGE
#undef PG8_LDA
#undef PG8_LDB
#undef PG8_MMA
#undef PG8_WAIT_V
#undef PG8_WAIT_L
#undef PG8_BAR
#undef PG8_SCHED
}
}
using pg8::Unit;

DI float rstd_row(const float* ss, int row) { return rsqrtf(ss[row] * (1.f / 1024.f) + EPS); }

struct EpiGU {
    static constexpr bool PERM = true;
    bf16_t* O; const float* ss;
    DI void operator()(const f32x4 (&acc)[2][2][4][2], const Unit& u, int wr, int wc, int fr, int fq) const {
        const int row0 = u.pm * 256 + wr * 64 + fr, col0 = u.pn * 128 + wc * 32 + 8 * fq;
#pragma unroll
        for (int ai = 0; ai < 2; ++ai)
#pragma unroll
            for (int m = 0; m < 4; ++m) {
                const int row = row0 + ai * 128 + m * 16; const float r = rstd_row(ss, row);
                float o[8];
#pragma unroll
                for (int n = 0; n < 2; ++n)
#pragma unroll
                    for (int e = 0; e < 4; ++e) { const float g = acc[ai][0][m][n][e] * r, up = acc[ai][1][m][n][e] * r; o[4 * n + e] = fsilu(g) * up; }
                u32x4 w; w.x = cvtpk(o[0], o[1]); w.y = cvtpk(o[2], o[3]); w.z = cvtpk(o[4], o[5]); w.w = cvtpk(o[6], o[7]);
                *(u32x4*)(O + (size_t)row * DFF + col0) = w;
            }
    }
};
template <bool NEXT> struct EpiRes {
    static constexpr bool PERM = false;
    const float* res_p; const float* res_s; float* out; bf16_t* xb; float* ss_out; float scale;
    DI void operator()(const f32x4 (&acc)[2][2][4][2], const Unit& u, int wr, int wc, int fr, int fq) const {
        const int row0 = u.pm * 256 + wr * 64 + fr, col0 = u.pn * 256 + wc * 32 + 4 * fq;
        const bool smp = u.pm >= 128;
#pragma unroll
        for (int ai = 0; ai < 2; ++ai)
#pragma unroll
            for (int m = 0; m < 4; ++m) {
                const int row = row0 + ai * 128 + m * 16;
                const float* rb = smp ? res_s + (size_t)(row - MP) * D : res_p + (size_t)row * D;
                float sq = 0.f;
#pragma unroll
                for (int bj = 0; bj < 2; ++bj)
#pragma unroll
                    for (int n = 0; n < 2; ++n) {
                        const int col = col0 + bj * 128 + n * 16;
                        const f32x4 b = *(const f32x4*)(rb + col);
                        const f32x4 x = b + acc[ai][bj][m][n] * scale;
                        *(f32x4*)(out + (size_t)row * D + col) = x;
                        if (NEXT) { u32x2 w; w.x = cvtpk(x[0], x[1]); w.y = cvtpk(x[2], x[3]); *(u32x2*)(xb + (size_t)row * D + col) = w;
                                    sq += (x[0] * x[0] + x[1] * x[1]) + (x[2] * x[2] + x[3] * x[3]); }
                    }
                if (NEXT) { sq += __shfl_xor(sq, 16); sq += __shfl_xor(sq, 32); if (fq == 0) atomicAdd(ss_out + row, sq); }
            }
    }
};
struct EpiIn {
    static constexpr bool PERM = true;
    const float* ss; const float* lbp;
    bf16_t *QT, *KT, *KH; float* DEC; bf16_t* SEG;
    float* outv_p; float* outv_s;
    DI void operator()(const f32x4 (&acc)[2][2][4][2], const Unit& u, int wr, int wc, int fr, int fq) const {
        const int row0 = u.pm * 256 + wr * 64 + fr;
        if (u.pn < 8) {
            const int chb = u.pn * 128 + wc * 32 + 8 * fq;
#pragma unroll
            for (int n = 0; n < 2; ++n) {
                const int ch = chb + 4 * n;
                const f32x4 a0 = *(const f32x4*)(lbp + ch), a1 = *(const f32x4*)(lbp + 1024 + ch);
                float lb[4];
#pragma unroll
                for (int e = 0; e < 4; ++e) lb[e] = __fdividef(1.f, 1.f + __expf(a1[e] - a0[e]));
#pragma unroll
                for (int ai = 0; ai < 2; ++ai)
#pragma unroll
                    for (int mm = 0; mm < 2; ++mm) {
                        const int R0 = row0 + ai * 128 + mm * 32, R1 = R0 + 16;
                        const float r0 = rstd_row(ss, R0), r1 = rstd_row(ss, R1);
                        float qt0[4], kt0[4], kh0[4], qt1[4], kt1[4], kh1[4], dc[4];
#pragma unroll
                        for (int e = 0; e < 4; ++e) {
                            const float f0 = lb[e] + (1.f - lb[e]) * fsigmoid(acc[ai][1][2 * mm][n][e] * r0);
                            const float f1 = lb[e] + (1.f - lb[e]) * fsigmoid(acc[ai][1][2 * mm + 1][n][e] * r1);
                            float p0 = __logf(f0), p1 = __logf(f1);
#pragma unroll
                            for (int d = 1; d < 16; d <<= 1) { const float t0 = __shfl_up(p0, d, 16), t1 = __shfl_up(p1, d, 16); if (fr >= d) { p0 += t0; p1 += t1; } }
                            const float tot0 = __shfl(p0, 15, 16);
                            p1 += tot0;
                            const float cl = __shfl(p1, 15, 16);
                            const float q0 = fsilu(acc[ai][0][2 * mm][n][e] * r0), q1 = fsilu(acc[ai][0][2 * mm + 1][n][e] * r1);
                            const float k0 = 1.f - f0, k1 = 1.f - f1;
                            qt0[e] = q0 * __expf(p0); kt0[e] = k0 * __expf(-p0); kh0[e] = k0 * __expf(cl - p0);
                            qt1[e] = q1 * __expf(p1); kt1[e] = k1 * __expf(-p1); kh1[e] = k1 * __expf(cl - p1);
                            dc[e] = __expf(cl);
                        }
                        const int cw = ch & 127;
                        const size_t f0 = ((size_t)(R0 >> 5) * 8 + u.pn) * 4096 + (size_t)(((cw >> 4) * 64 + ((cw >> 2) & 1) * 32 + (R0 & 31)) * 8 + ((cw >> 3) & 1) * 4);
                        const size_t f1 = f0 + 16 * 8;
                        u32x2 w;
                        w.x = cvtpk(qt0[0], qt0[1]); w.y = cvtpk(qt0[2], qt0[3]); *(u32x2*)(QT + f0) = w;
                        w.x = cvtpk(kt0[0], kt0[1]); w.y = cvtpk(kt0[2], kt0[3]); *(u32x2*)(KT + f0) = w;
                        w.x = cvtpk(kh0[0], kh0[1]); w.y = cvtpk(kh0[2], kh0[3]); *(u32x2*)(KH + (size_t)R0 * D + ch) = w;
                        w.x = cvtpk(qt1[0], qt1[1]); w.y = cvtpk(qt1[2], qt1[3]); *(u32x2*)(QT + f1) = w;
                        w.x = cvtpk(kt1[0], kt1[1]); w.y = cvtpk(kt1[2], kt1[3]); *(u32x2*)(KT + f1) = w;
                        w.x = cvtpk(kh1[0], kh1[1]); w.y = cvtpk(kh1[2], kh1[3]); *(u32x2*)(KH + (size_t)R1 * D + ch) = w;
                        if (fr == 15) *(f32x4*)(DEC + (size_t)(R1 >> 5) * D + ch) = (f32x4){dc[0], dc[1], dc[2], dc[3]};
                    }
            }
        } else {
            const int seg = (u.pn >> 2) - 2;
            bf16_t* base = SEG + (size_t)seg * (SZB / 2);
            const int col0 = (u.pn & 3) * 256 + wc * 32 + 8 * fq;
            const bool isv = seg == 4, isqk = seg == 2 || seg == 3; const bool smp = u.pm >= 128;
#pragma unroll
            for (int ai = 0; ai < 2; ++ai)
#pragma unroll
                for (int m = 0; m < 4; ++m) {
                    const int row = row0 + ai * 128 + m * 16; const float r = rstd_row(ss, row);
#pragma unroll
                    for (int bj = 0; bj < 2; ++bj) {
                        const f32x4 v0 = acc[ai][bj][m][0] * r, v1 = acc[ai][bj][m][1] * r;
                        u32x4 w; w.x = cvtpk(v0[0], v0[1]); w.y = cvtpk(v0[2], v0[3]); w.z = cvtpk(v1[0], v1[1]); w.w = cvtpk(v1[2], v1[3]);
                        const int col = col0 + bj * 128;
                        if (isqk) *(u32x4*)(base + ((size_t)(row >> 5) * 8 + (col >> 7)) * 4096 + (size_t)((((col & 127) >> 4) * 64 + ((col >> 3) & 1) * 32 + (row & 31)) * 8)) = w;
                        else *(u32x4*)(base + (size_t)row * D + col) = w;
                        if (isv) { float* o = (smp ? outv_s + (size_t)(row - MP) * D : outv_p + (size_t)row * D) + col0 + bj * 128;
                                   *(f32x4*)o = v0; *(f32x4*)(o + 4) = v1; }
                    }
                }
        }
    }
};
struct EpiCin {
    static constexpr bool PERM = true;
    const float* ss; bf16_t* U; bf16_t* V; float* vst;
    DI void operator()(const f32x4 (&acc)[2][2][4][2], const Unit& u, int wr, int wc, int fr, int fq) const {
        const int row0 = u.pm * 256 + wr * 64 + fr;
        const bool isv = u.pn >= 8;
        bf16_t* base = isv ? V : U;
        const int col0 = (u.pn & 7) * 256 + wc * 32 + 8 * fq;
#pragma unroll
        for (int ai = 0; ai < 2; ++ai)
#pragma unroll
            for (int m = 0; m < 4; ++m) {
                const int row = row0 + ai * 128 + m * 16; const float r = rstd_row(ss, row);
                float s1 = 0.f, s2 = 0.f;
#pragma unroll
                for (int bj = 0; bj < 2; ++bj) {
                    float o[8];
#pragma unroll
                    for (int n = 0; n < 2; ++n)
#pragma unroll
                        for (int e = 0; e < 4; ++e) { const float v = fgelu(acc[ai][bj][m][n][e] * r); o[4 * n + e] = v; s1 += v; s2 += v * v; }
                    u32x4 w; w.x = cvtpk(o[0], o[1]); w.y = cvtpk(o[2], o[3]); w.z = cvtpk(o[4], o[5]); w.w = cvtpk(o[6], o[7]);
                    *(u32x4*)(base + (size_t)row * 2048 + col0 + bj * 128) = w;
                }
                if (isv) { s1 += __shfl_xor(s1, 16); s1 += __shfl_xor(s1, 32); s2 += __shfl_xor(s2, 16); s2 += __shfl_xor(s2, 32);
                           if (fq == 0) { atomicAdd(vst + 2 * row, s1); atomicAdd(vst + 2 * row + 1, s2); } }
            }
    }
};

struct Ctx {
    const float* const* in; float* out; unsigned char* ws;
    bf16_t *QT, *KT, *KH, *VA, *GA, *QB, *KB, *VB, *MIX; float* DEC;
};

DI void transpose_item(const float* W, int N, int K, bf16_t* WT, int drow0, int k0, int n0, const float* gain, LAS float* scr, int lane) {
    const int c4 = (lane & 15) * 4, kr = lane >> 4;
#pragma unroll 4
    for (int i = 0; i < 16; ++i) { const int kk = 4 * i + kr; f32x4 v = *(const f32x4*)(W + (size_t)(k0 + kk) * N + n0 + c4); if (gain) v *= gain[k0 + kk];
        LAS float* d = scr + kk * 65 + c4; d[0] = v[0]; d[1] = v[1]; d[2] = v[2]; d[3] = v[3]; }
    asm volatile("s_waitcnt lgkmcnt(0)" ::: "memory");
    const int c = lane & 7;
#pragma unroll
    for (int j = 0; j < 8; ++j) { const int n = (lane >> 3) + 8 * j; const LAS float* sp = scr + (8 * c) * 65 + n;
        u32x4 o; o.x = cvtpk(sp[0 * 65], sp[1 * 65]); o.y = cvtpk(sp[2 * 65], sp[3 * 65]); o.z = cvtpk(sp[4 * 65], sp[5 * 65]); o.w = cvtpk(sp[6 * 65], sp[7 * 65]);
        *(u32x4*)(WT + (size_t)(drow0 + n) * K + k0 + 8 * c) = o; }
    asm volatile("s_waitcnt lgkmcnt(0)" ::: "memory");
}
constexpr int CV_GU = 16 * 44, CV_D = 44 * 16, CV_IN = 16 * 112, CV_O = 32 * 16, CV_CI = 16 * 64;
constexpr int CV_D0 = 8 * CV_GU, CV_W0 = CV_D0 + 4 * CV_D, CV_END = CV_W0 + CV_IN + CV_O + CV_CI + CV_O;
DI void conv_items(const Params& p, LAS unsigned char* lds, int lo0, int hi0, int lo1, int hi1, int lo2, int hi2, int rank, int nranks, int wave, int lane) {
    LAS float* scr = (LAS float*)(lds + wave * 18432);
    unsigned char* ws = p.ws;
    constexpr int I_GU = 16 * 44, I_D = 44 * 16, I_IN = 16 * 112, I_O = 32 * 16, I_CI = 16 * 64;
    constexpr int NITEMS = 8 * I_GU + 4 * I_D + I_IN + I_O + I_CI + I_O;
    (void)NITEMS;
    const int n0_ = hi0 - lo0, n1_ = hi1 - lo1, n2_ = hi2 - lo2;
    for (int it = rank; it < n0_ + n1_ + n2_; it += nranks) {
        int r = it < n0_ ? lo0 + it : (it < n0_ + n1_ ? lo1 + (it - n0_) : lo2 + (it - n0_ - n1_));
        if (r < 8 * I_GU) {
            const int mat = r / I_GU, item = r % I_GU, f = mat >> 1, up = mat & 1, l = f >> 1, second = f & 1;
            const float* W = p.in[second ? (up ? 12 : 11) : (up ? 7 : 6)] + (size_t)l * D * DFF;
            const float* gain = p.in[second ? 10 : 5] + l * D;
            const int kb = item / 44, nb = item % 44, n0 = nb * 64;
            const int drow0 = (n0 >> 7) * 256 + up * 128 + (n0 & 127);
            transpose_item(W, DFF, D, (bf16_t*)(ws + WS_WGU) + (size_t)f * 5632 * 1024, drow0, kb * 64, n0, gain, scr, lane);
            continue;
        }
        r -= 8 * I_GU;
        if (r < 4 * I_D) {
            const int f = r / I_D, item = r % I_D, l = f >> 1, second = f & 1;
            const float* W = p.in[second ? 13 : 8] + (size_t)l * DFF * D;
            const int kb = item / 16, nb = item % 16;
            transpose_item(W, D, DFF, (bf16_t*)(ws + WS_WD) + (size_t)f * 1024 * DFF, nb * 64, kb * 64, nb * 64, nullptr, scr, lane);
            continue;
        }
        r -= 4 * I_D;
        if (r < I_IN) {
            const int kb = r / 112, nb = r % 112, n0 = nb * 64, seg = n0 >> 10, w = n0 & 1023;
            const int drow0 = seg == 0 ? (w >> 7) * 256 + (w & 127) : (seg == 1 ? (w >> 7) * 256 + 128 + (w & 127) : n0);
            transpose_item(p.in[14], 7168, D, (bf16_t*)(ws + WS_WIN), drow0, kb * 64, n0, p.in[9], scr, lane);
            continue;
        }
        r -= I_IN;
        if (r < I_O) { const int kb = r / 16, nb = r % 16; transpose_item(p.in[19], D, 2048, (bf16_t*)(ws + WS_WOUT), nb * 64, kb * 64, nb * 64, nullptr, scr, lane); continue; }
        r -= I_O;
        if (r < I_CI) { const int kb = r / 64, nb = r % 64; transpose_item(p.in[20], 4096, D, (bf16_t*)(ws + WS_WCIN), nb * 64, kb * 64, nb * 64, p.in[9] + D, scr, lane); continue; }
        r -= I_CI;
        { const int kb = r / 16, nb = r % 16; transpose_item(p.in[25], D, 2048, (bf16_t*)(ws + WS_WCOUT), nb * 64, kb * 64, nb * 64, nullptr, scr, lane); }
    }
}
DI void prologue(const Params& p, LAS unsigned char* lds, int gw, int NGW, int wave, int lane) {
    unsigned char* ws = p.ws;
    conv_items(p, lds, 0, 2 * CV_GU, 0, 0, 0, 0, gw, NGW, wave, lane);
    float* ss = (float*)(ws + WS_SS);
    bf16_t* xb = (bf16_t*)(ws + WS_XB);
#pragma unroll 2
    for (int m = gw; m < M; m += NGW) {
        const float* xr = (m < MP) ? p.in[0] + (size_t)m * D : p.in[1] + (size_t)(m - MP) * D;
        float s = 0.f;
#pragma unroll
        for (int j = 0; j < 4; ++j) { const f32x4 v = *(const f32x4*)(xr + 4 * lane + 256 * j); s += (v[0] * v[0] + v[1] * v[1]) + (v[2] * v[2] + v[3] * v[3]);
            u32x2 w; w.x = cvtpk(v[0], v[1]); w.y = cvtpk(v[2], v[3]); *(u32x2*)(xb + (size_t)m * D + 4 * lane + 256 * j) = w; }
        s = wave_sum(s);
        if (lane == 0) ss[m] = s;
    }
    const int gt = gw * 64 + lane, GT = NGW * 64;
    for (int i = gt; i < 7 * M; i += GT) ss[M + i] = 0.f;
}

template <int STAGE> DI void conv_stage(const Params& p, LAS unsigned char* lds, int rank, int nranks, int wave, int lane) {
    const int r8 = rank * 8 + wave, n8 = nranks * 8;
    if (STAGE == 1) conv_items(p, lds, CV_D0, CV_D0 + CV_D, CV_W0, CV_W0 + CV_IN, 0, 0, r8, n8, wave, lane);
    if (STAGE == 2) conv_items(p, lds, CV_W0 + CV_IN, CV_W0 + CV_IN + CV_O, 2 * CV_GU, 4 * CV_GU, CV_D0 + CV_D, CV_D0 + 2 * CV_D, r8, n8, wave, lane);
    if (STAGE == 3) conv_items(p, lds, 4 * CV_GU, 6 * CV_GU, CV_D0 + 2 * CV_D, CV_D0 + 3 * CV_D, 0, 0, r8, n8, wave, lane);
    if (STAGE == 4) conv_items(p, lds, CV_W0 + CV_IN + CV_O, CV_END, 6 * CV_GU, 8 * CV_GU, CV_D0 + 3 * CV_D, CV_D0 + 4 * CV_D, r8, n8, wave, lane);
}

template <class T> DI T ldg(const void* sbase, unsigned voff) { return *(const T*)((const char*)sbase + voff); }
template <class T> DI void stg(void* sbase, unsigned voff, T v) { *(T*)((char*)sbase + voff) = v; }

DI void dma16(const void* g, LAS unsigned char* l) { __builtin_amdgcn_global_load_lds((const unsigned*)g, (LAS unsigned*)l, 16, 0, 0); }
#define VM_WAIT0() asm volatile("s_waitcnt vmcnt(0)" ::: "memory")
#define LGKM_WAIT0() asm volatile("s_waitcnt lgkmcnt(0)" ::: "memory")

constexpr int HG_BUF = 11264;
DI void hgrn_item(const Ctx& C, LAS unsigned char* wl, int lane, size_t row0, int nblk, int h, int dvs, const float* s0, float* sout) {
    asm volatile("" : "+v"(lane));
    const int r = lane & 31, hh = lane >> 5, i16 = lane & 15, q = i16 >> 2, p = i16 & 3, g16 = (lane >> 4) & 1;
    const unsigned offF = (unsigned)lane * 16u;
    const unsigned offKH = (unsigned)((lane >> 4) * D) * 2u + (unsigned)(((lane & 15) ^ (((lane >> 4) & 3) << 2)) * 16);
    const unsigned offVA = (unsigned)((lane >> 2) * D) * 2u + (unsigned)((lane & 3) * 16);
    const unsigned offDC = (unsigned)((lane & 31) * 16);
    const unsigned offO = (unsigned)(4 * hh * 2048 + r) * 2u, offS = (unsigned)(4 * hh * 128 + r) * 4u;
    f32x16 S[4];
#pragma unroll
    for (int dkb = 0; dkb < 4; ++dkb)
#pragma unroll
        for (int i = 0; i < 16; ++i) S[dkb][i] = s0 ? ldg<float>(s0 + (size_t)(32 * dkb + (i & 3) + 8 * (i >> 2)) * 128 + 32 * dvs, offS) : 0.f;
    const unsigned vrd = (unsigned)((4 * hh + q) * 64 + 32 * g16 + 8 * p) + 8192u;
    unsigned krd[4];
#pragma unroll
    for (int dkb = 0; dkb < 4; ++dkb) krd[dkb] = (unsigned)((4 * hh + q) * 256 + (((dkb ^ q) * 4 + 2 * g16 + (p >> 1)) * 16) + (p & 1) * 8);
    const unsigned drd = 10240u + 16u * hh;
    u32x4 qn[8], kn[8];
#define HG_ISSUE(blk_, buf_) do { const size_t t1_ = row0 + 32 * (size_t)(blk_); LAS unsigned char* bb_ = wl + (buf_) * HG_BUF; \
        const bf16_t* KHb_ = C.KH + t1_ * D + h * 128; const bf16_t* VAb_ = C.VA + t1_ * D + h * 128 + dvs * 32; const float* DCb_ = C.DEC + (t1_ >> 5) * D + h * 128; \
        _Pragma("unroll") for (int j_ = 0; j_ < 8; ++j_) dma16((const char*)(KHb_ + (size_t)j_ * 4 * D) + offKH, bb_ + j_ * 1024); \
        _Pragma("unroll") for (int j_ = 0; j_ < 2; ++j_) dma16((const char*)(VAb_ + (size_t)j_ * 16 * D) + offVA, bb_ + 8192 + j_ * 1024); \
        dma16((const char*)DCb_ + offDC, bb_ + 10240); \
        const bf16_t* QTb_ = C.QT + ((t1_ >> 5) * 8 + h) * 4096; const bf16_t* KTb_ = C.KT + ((t1_ >> 5) * 8 + h) * 4096; \
        _Pragma("unroll") for (int kk_ = 0; kk_ < 8; ++kk_) { qn[kk_] = ldg<u32x4>(QTb_ + 512 * kk_, offF); kn[kk_] = ldg<u32x4>(KTb_ + 512 * kk_, offF); } } while (0)
    LGKM_WAIT0();
    HG_ISSUE(0, 0);
    for (int blk = 0; blk < nblk; ++blk) {
        const size_t t0 = row0 + 32 * (size_t)blk;
        const LAS unsigned char* bb = wl + (blk & 1) * HG_BUF;
        bf16_t* MXb = C.MIX + t0 * 2048 + h * 128 + dvs * 32;
        VM_WAIT0();
        bf16x8 qf[8];
        f32x16 sc;
#pragma unroll
        for (int i = 0; i < 16; ++i) sc[i] = 0.f;
#pragma unroll
        for (int kk = 0; kk < 8; ++kk) { qf[kk] = __builtin_bit_cast(bf16x8, qn[kk]); sc = MFMA32(__builtin_bit_cast(bf16x8, kn[kk]), qf[kk], sc); }
#pragma unroll
        for (int i = 0; i < 16; ++i) if (crow(i, hh) > r) sc[i] = 0.f;
        FENCE();
        if (blk + 1 < nblk) HG_ISSUE(blk + 1, (blk + 1) & 1);
        FENCE();
        bf16x8 vf[2];
#pragma unroll
        for (int ks = 0; ks < 2; ++ks) vf[ks] = cat8(vtr(bb + vrd + 16 * ks * 64), vtr(bb + vrd + (16 * ks + 8) * 64));
        f32x16 o;
#pragma unroll
        for (int i = 0; i < 16; ++i) o[i] = 0.f;
#pragma unroll
        for (int ks = 0; ks < 2; ++ks) o = MFMA32(pack8(sc, ks), vf[ks], o);
#pragma unroll
        for (int dkb = 0; dkb < 4; ++dkb)
#pragma unroll
            for (int ks = 0; ks < 2; ++ks) o = MFMA32(qf[2 * dkb + ks], pack8(S[dkb], ks), o);
#pragma unroll
        for (int i = 0; i < 16; ++i) stg<bf16_t>(MXb + (size_t)((i & 3) + 8 * (i >> 2)) * 2048, offO, f2bf(o[i]));
#pragma unroll
        for (int dkb = 0; dkb < 4; ++dkb) {
#pragma unroll
            for (int g4 = 0; g4 < 4; ++g4) { const f32x4 dv = *(const LAS f32x4*)(bb + drd + (32 * dkb + 8 * g4) * 4);
#pragma unroll
                for (int e = 0; e < 4; ++e) S[dkb][4 * g4 + e] *= dv[e]; }
#pragma unroll
            for (int ks = 0; ks < 2; ++ks) {
                const bf16x8 kh = cat8(vtr(bb + krd[dkb] + 16 * ks * 256), vtr(bb + krd[dkb] + (16 * ks + 8) * 256));
                S[dkb] = MFMA32(kh, vf[ks], S[dkb]);
            }
        }
    }
#undef HG_ISSUE
#pragma unroll
    for (int dkb = 0; dkb < 4; ++dkb)
#pragma unroll
        for (int i = 0; i < 16; ++i) stg<float>(sout + (size_t)(32 * dkb + (i & 3) + 8 * (i >> 2)) * 128 + 32 * dvs, offS, S[dkb][i]);
}

template <bool SAMPLE>
DI void attn_unit(const Ctx& C, LAS unsigned char* wl, int lane, int b, int h, int qb) {
    asm volatile("" : "+v"(lane));
    const int r = lane & 31, hh = lane >> 5, i16 = lane & 15, q = i16 >> 2, p = i16 & 3, g16 = (lane >> 4) & 1;
    const size_t qrow0 = SAMPLE ? (size_t)MP + b * 32 : (size_t)b * SEQ + qb * 32;
    const float* gq = C.in[17]; const float* gk = C.in[18];
    const unsigned offF = (unsigned)(r * D + 8 * hh) * 2u;
    const unsigned offL = (unsigned)lane * 16u;
    const unsigned offG = (unsigned)(8 * hh) * 4u;
    const unsigned swz = (unsigned)(((lane & 15) ^ (((lane >> 4) & 3) << 2)) * 16);
    const unsigned offVd = (unsigned)((lane >> 4) * D) * 2u + swz;
    const unsigned offV = (unsigned)((lane >> 4) * D + (lane & 15) * 8) * 2u;
    const unsigned offO = (unsigned)(4 * hh * 2048 + r) * 2u;
    LAS unsigned char* vwr = wl + (lane >> 4) * 256 + swz;
    unsigned vrd[4];
#pragma unroll
    for (int db = 0; db < 4; ++db) vrd[db] = (unsigned)((4 * hh + q) * 256 + (((db ^ q) * 4 + 2 * g16 + (p >> 1)) * 16) + (p & 1) * 8);
    LAS unsigned char* qimg = wl + 8192 + lane * 16;
    LGKM_WAIT0();
    {
        u32x4 raw[8]; float ss = 0.f;
        const bf16_t* src = C.QB + ((qrow0 >> 5) * 8 + h) * 4096;
#pragma unroll
        for (int s = 0; s < 8; ++s) { raw[s] = ldg<u32x4>(src + 512 * s, offL);
#pragma unroll
            for (int e = 0; e < 4; ++e) { const float a = bflo(raw[s][e]), c = bfhi(raw[s][e]); ss += a * a + c * c; } }
        ss += __shfl_xor(ss, 32);
        const float rs = rsqrtf(ss * (1.f / 128.f) + EPS) * 0.08838834764831845f;
#pragma unroll
        for (int s = 0; s < 8; ++s) { f32x4 g0 = ldg<f32x4>(gq + 16 * s, offG), g1 = ldg<f32x4>(gq + 16 * s + 4, offG);
            if (!SAMPLE) { g0 *= ldg<f32x4>(gk + 16 * s, offG); g1 *= ldg<f32x4>(gk + 16 * s + 4, offG); }
            u32x4 w; w.x = cvtpk(bflo(raw[s].x) * rs * g0[0], bfhi(raw[s].x) * rs * g0[1]); w.y = cvtpk(bflo(raw[s].y) * rs * g0[2], bfhi(raw[s].y) * rs * g0[3]);
            w.z = cvtpk(bflo(raw[s].z) * rs * g1[0], bfhi(raw[s].z) * rs * g1[1]); w.w = cvtpk(bflo(raw[s].w) * rs * g1[2], bfhi(raw[s].w) * rs * g1[3]);
            *(LAS u32x4*)(qimg + s * 1024) = w; }
    }
    f32x16 O[4];
#pragma unroll
    for (int db = 0; db < 4; ++db)
#pragma unroll
        for (int i = 0; i < 16; ++i) O[db][i] = 0.f;
    float R = 0.f;
    const int ntiles = SAMPLE ? 65 : qb + 1;
    u32x4 kr[8];
    if (!SAMPLE) {
        const bf16_t* src = C.KB + ((qrow0 >> 5) * 8 + h) * 4096; const bf16_t* vsrc = C.VB + qrow0 * D + h * 128;
#pragma unroll
        for (int s = 0; s < 8; ++s) kr[s] = ldg<u32x4>(src + 512 * s, offL);
#pragma unroll
        for (int j = 0; j < 8; ++j) dma16((const char*)(vsrc + (size_t)j * 4 * D) + offVd, wl + j * 1024);
    }
    for (int it = 0; it < ntiles; ++it) {
        const bool diag = it == 0;
        const bool cache = SAMPLE && !diag;
        f32x16 z;
#pragma unroll
        for (int i = 0; i < 16; ++i) z[i] = 0.f;
        if (!cache) {
            const size_t krow0 = SAMPLE ? (size_t)MP + b * 32 : (size_t)b * SEQ + (qb - it) * 32;
            float ss = 0.f;
            if (SAMPLE) { const bf16_t* src = C.KB + ((krow0 >> 5) * 8 + h) * 4096;
#pragma unroll
                for (int s = 0; s < 8; ++s) kr[s] = ldg<u32x4>(src + 512 * s, offL); }
#pragma unroll
            for (int s = 0; s < 8; ++s)
#pragma unroll
                for (int e = 0; e < 4; ++e) { const float a = bflo(kr[s][e]), c = bfhi(kr[s][e]); ss += a * a + c * c; }
            ss += __shfl_xor(ss, 32);
            const float rs = rsqrtf(ss * (1.f / 128.f) + EPS);
            if (diag) {
                float* ko = (SAMPLE ? C.out + OUT_KS + (size_t)b * 32 * D : C.out + OUT_KP + krow0 * D) + h * 128;
#pragma unroll
                for (int s = 0; s < 8; ++s) { const f32x4 g0 = ldg<f32x4>(gk + 16 * s, offG), g1 = ldg<f32x4>(gk + 16 * s + 4, offG);
                    const f32x4 k0 = {bflo(kr[s].x) * rs * g0[0], bfhi(kr[s].x) * rs * g0[1], bflo(kr[s].y) * rs * g0[2], bfhi(kr[s].y) * rs * g0[3]};
                    const f32x4 k1 = {bflo(kr[s].z) * rs * g1[0], bfhi(kr[s].z) * rs * g1[1], bflo(kr[s].w) * rs * g1[2], bfhi(kr[s].w) * rs * g1[3]};
                    stg<f32x4>(ko + 16 * s, offF * 2u, k0); stg<f32x4>(ko + 16 * s + 4, offF * 2u, k1);
                    if (SAMPLE) z = MFMA32(pack8f(k0, k1), *(const LAS bf16x8*)(qimg + s * 1024), z);
                    if ((s & 3) == 3) FENCE(); }
            }
            if (!SAMPLE) {
#pragma unroll
                for (int s = 0; s < 8; ++s) z = MFMA32(__builtin_bit_cast(bf16x8, kr[s]), *(const LAS bf16x8*)(qimg + s * 1024), z);
#pragma unroll
                for (int i = 0; i < 16; ++i) { const float ra = __builtin_bit_cast(float, __builtin_amdgcn_readlane(__builtin_bit_cast(int, rs), (i & 3) + 8 * (i >> 2))),
                                                           rb = __builtin_bit_cast(float, __builtin_amdgcn_readlane(__builtin_bit_cast(int, rs), (i & 3) + 8 * (i >> 2) + 4));
                    z[i] *= hh ? rb : ra; }
                FENCE();
                if (it + 1 < ntiles) {
                    const bf16_t* src = C.KB + (((krow0 - 32) >> 5) * 8 + h) * 4096;
#pragma unroll
                    for (int s = 0; s < 8; ++s) kr[s] = ldg<u32x4>(src + 512 * s, offL);
                }
                FENCE();
            } else {
                FENCE();
                const bf16_t* vsrc = C.VB + krow0 * D + h * 128;
#pragma unroll
                for (int i8 = 0; i8 < 8; ++i8) { *(LAS u32x4*)(vwr + i8 * 1024) = ldg<u32x4>(vsrc + (size_t)i8 * 4 * D, offV); if ((i8 & 3) == 3) FENCE(); }
            }
        } else {
            const int kt = 64 - it;
            const float* src = C.in[2] + ((size_t)b * 2048 + kt * 32) * D + h * 128;
#pragma unroll
            for (int s = 0; s < 8; ++s) { const f32x4 k0 = ldg<f32x4>(src + 16 * s, offF * 2u), k1 = ldg<f32x4>(src + 16 * s + 4, offF * 2u); z = MFMA32(pack8f(k0, k1), *(const LAS bf16x8*)(qimg + s * 1024), z); if ((s & 3) == 3) FENCE(); }
            const float* vsrc = C.in[3] + ((size_t)b * 2048 + kt * 32) * D + h * 128;
#pragma unroll
            for (int i8 = 0; i8 < 8; ++i8) { const f32x4 v0 = ldg<f32x4>(vsrc + (size_t)i8 * 4 * D, offV * 2u), v1 = ldg<f32x4>(vsrc + (size_t)i8 * 4 * D + 4, offV * 2u);
                *(LAS bf16x8*)(vwr + i8 * 1024) = pack8f(v0, v1); if (i8 & 1) FENCE(); }
        }
        FENCE();
        float ls[16];
#pragma unroll
        for (int i = 0; i < 16; ++i) { const float zz = z[i]; ls[i] = -(fmaxf(zz, 0.f) + __logf(1.f + __expf(-fabsf(zz)))); }
        if (diag) {
#pragma unroll
            for (int i = 0; i < 16; ++i) if (crow(i, hh) >= r) { ls[i] = 0.f; z[i] = -INFINITY; }
        }
        float gs[4], og[4];
#pragma unroll
        for (int g = 0; g < 4; ++g) { gs[g] = (ls[4 * g] + ls[4 * g + 1]) + (ls[4 * g + 2] + ls[4 * g + 3]); og[g] = __shfl_xor(gs[g], 32); }
        float tail = R;
#pragma unroll
        for (int g = 3; g >= 0; --g) {
            float run = tail + (hh == 0 ? og[g] : 0.f);
#pragma unroll
            for (int e = 3; e >= 0; --e) { const float l = ls[4 * g + e]; z[4 * g + e] = __expf(z[4 * g + e] + l + run); run += l; }
            tail += gs[g] + og[g];
        }
        R = tail;
        FENCE();
        if (!SAMPLE) VM_WAIT0();
#pragma unroll
        for (int ks = 0; ks < 2; ++ks) {
            const bf16x8 pa = pack8(z, ks);
#pragma unroll
            for (int db = 0; db < 4; ++db) {
                const bf16x8 vf = cat8(vtr(wl + vrd[db] + 16 * ks * 256), vtr(wl + vrd[db] + (16 * ks + 8) * 256));
                O[db] = MFMA32(pa, vf, O[db]);
            }
        }
        if (__all(R < -30.f)) break;
        if (!SAMPLE && it + 1 < ntiles) {
            LGKM_WAIT0();
            const bf16_t* vsrc = C.VB + ((size_t)b * SEQ + (qb - it - 1) * 32) * D + h * 128;
#pragma unroll
            for (int j = 0; j < 8; ++j) dma16((const char*)(vsrc + (size_t)j * 4 * D) + offVd, wl + j * 1024);
        }
    }
    bf16_t* mo = C.MIX + qrow0 * 2048 + 1024 + h * 128;
#pragma unroll
    for (int db = 0; db < 4; ++db)
#pragma unroll
        for (int i = 0; i < 16; ++i) stg<bf16_t>(mo + (size_t)((i & 3) + 8 * (i >> 2)) * 2048 + 32 * db, offO, f2bf(O[db][i]));
}

DI void spatial_unit(const Params& P, LAS unsigned char* wl, int lane, int unit) {
    asm volatile("" : "+v"(lane));
    const int r = lane & 31, hh = lane >> 5, i16 = lane & 15, q = i16 >> 2, p = i16 & 3, g16 = (lane >> 4) & 1;
    const bool sample = unit >= 8192;
    const int uu = sample ? unit - 8192 : unit;
    const int cs = uu & 3, g = (uu >> 2) & 7, chunk = uu >> 5;
    const size_t rbase = sample ? (size_t)MP + chunk * 32 : (size_t)chunk * 128;
    const int L = sample ? 32 : 128;
    const int c0 = g * 256 + cs * 64;
    const bf16_t* U = (const bf16_t*)(P.ws + WS_U) + rbase * 2048 + c0; const bf16_t* V = (const bf16_t*)(P.ws + WS_V) + rbase * 2048 + c0; bf16_t* GT = (bf16_t*)(P.ws + WS_GATED) + rbase * 2048 + c0;
    const float* vst = (const float*)(P.ws + WS_VST) + 2 * rbase;
    const float* lng = P.in[21] + c0; const float* lnb = P.in[22] + c0; const float* wsp = P.in[23] + (size_t)g * 128 * 128; const float* bsp = P.in[24] + g * 128;
    {
        const int ch = lane & 7;
        const unsigned offC = (unsigned)(ch * 8) * 4u;
        const f32x4 ga = ldg<f32x4>(lng, offC), gb = ldg<f32x4>(lng + 4, offC), ba = ldg<f32x4>(lnb, offC), bb = ldg<f32x4>(lnb + 4, offC);
        const unsigned offR = (unsigned)((lane >> 3) * 2048 + ch * 8) * 2u, offS = (unsigned)(lane >> 3) * 8u;
        LAS unsigned char* wr_ = wl + (ch >> 2) * 8192 + (lane >> 3) * 64 + (ch & 3) * 16;
        float* gvo = P.out + OUT_GV + (size_t)chunk * 32 * 2048 + c0;
#pragma unroll 4
        for (int it = 0; it < L / 8; ++it) {
            const u32x4 raw = ldg<u32x4>(V + (size_t)it * 8 * 2048, offR);
            const f32x2_t st = ldg<f32x2_t>(vst + it * 16, offS);
            const float mean = st.x * (1.f / 2048.f), var = st.y * (1.f / 2048.f) - mean * mean, rs = rsqrtf(fmaxf(var, 0.f) + EPS);
            f32x4 x0 = {bflo(raw.x), bfhi(raw.x), bflo(raw.y), bfhi(raw.y)}, x1 = {bflo(raw.z), bfhi(raw.z), bflo(raw.w), bfhi(raw.w)};
            x0 = (x0 - mean) * rs * ga + ba; x1 = (x1 - mean) * rs * gb + bb;
            if (sample) { stg<f32x4>(gvo + (size_t)it * 8 * 2048, offR * 2u, x0); stg<f32x4>(gvo + (size_t)it * 8 * 2048 + 4, offR * 2u, x1); }
            *(LAS bf16x8*)(wr_ + it * 8 * 64) = pack8f(x0, x1);
        }
    }
    const LAS unsigned char* brd = wl + (8 * hh + q) * 64 + 32 * g16 + 8 * p;
    bf16x8 bfr[2][8];
#pragma unroll
    for (int db = 0; db < 2; ++db)
#pragma unroll
        for (int kk = 0; kk < 8; ++kk)
            if (kk * 16 < L) bfr[db][kk] = cat8(vtr(brd + db * 8192 + 16 * kk * 64), vtr(brd + db * 8192 + (16 * kk + 4) * 64));
            else bfr[db][kk] = (bf16x8){0, 0, 0, 0, 0, 0, 0, 0};
    const int ntile = L / 32;
    const unsigned offW = (unsigned)(r * 128 + 8 * hh) * 4u, offU = (unsigned)(4 * hh * 2048 + r) * 2u, offB = (unsigned)(4 * hh) * 4u;
    for (int itile = 0; itile < ntile; ++itile) {
        const int nk = sample ? 2 : (itile < 2 ? 4 : 8);
        f32x16 a0, a1;
#pragma unroll
        for (int i = 0; i < 16; ++i) { a0[i] = 0.f; a1[i] = 0.f; }
        const float* wrow = wsp + (size_t)(32 * itile) * 128;
        const bf16_t* Ut = U + (size_t)(32 * itile) * 2048; bf16_t* Gt = GT + (size_t)(32 * itile) * 2048; const float* bt = bsp + 32 * itile;
        bf16_t uv0[16], uv1[16]; float bsv[16];
#pragma unroll
        for (int i = 0; i < 16; ++i) { const int io = (i & 3) + 8 * (i >> 2);
            bsv[i] = ldg<float>(bt + io, offB); uv0[i] = ldg<bf16_t>(Ut + (size_t)io * 2048, offU); uv1[i] = ldg<bf16_t>(Ut + (size_t)io * 2048 + 32, offU); }
#pragma unroll
        for (int kk = 0; kk < 8; ++kk) if (kk < nk) {
            const f32x4 w0 = ldg<f32x4>(wrow + 16 * kk, offW), w1 = ldg<f32x4>(wrow + 16 * kk + 4, offW);
            const bf16x8 af = pack8f(w0, w1);
            a0 = MFMA32(af, bfr[0][kk], a0); a1 = MFMA32(af, bfr[1][kk], a1);
        }
#pragma unroll
        for (int i = 0; i < 16; ++i) {
            const int io = (i & 3) + 8 * (i >> 2);
            stg<bf16_t>(Gt + (size_t)io * 2048, offU, f2bf(bf2f(uv0[i]) * (a0[i] + bsv[i]))); stg<bf16_t>(Gt + (size_t)io * 2048 + 32, offU, f2bf(bf2f(uv1[i]) * (a1[i] + bsv[i])));
        }
    }
}


template <bool NEXT>
DI void small_gemm_res(LAS unsigned char* lds, const bf16_t* A  , const bf16_t* Bt  , int K, const float* res  ,
                       float* out, bf16_t* xb, float* ss_out, float scale, int unit0, int G) {
    int tid = threadIdx.x; asm volatile("" : "+v"(tid));
    const int lane = tid & 63, wave = __builtin_amdgcn_readfirstlane(tid >> 6), r = lane & 31, hh = lane >> 5;
    const int Kw = K >> 3;
    const unsigned offA = (unsigned)(r * K + 8 * hh) * 2u;
    for (int unit = unit0; unit < 256; unit += G) {
        const int tm = unit >> 4, tn = unit & 15;
        const bf16_t* A0 = A + (size_t)(tm * 64) * K + wave * Kw; const bf16_t* A1 = A0 + (size_t)32 * K;
        const bf16_t* B0 = Bt + (size_t)(tn * 64) * K + wave * Kw; const bf16_t* B1 = B0 + (size_t)32 * K;
        f32x16 c00, c01, c10, c11;
#pragma unroll
        for (int i = 0; i < 16; ++i) { c00[i] = 0.f; c01[i] = 0.f; c10[i] = 0.f; c11[i] = 0.f; }
        u32x4 a0[2], a1[2], b0[2], b1[2], an0[2], an1[2], bn0[2], bn1[2];
#pragma unroll
        for (int j = 0; j < 2; ++j) { a0[j] = ldg<u32x4>(A0 + 16 * j, offA); a1[j] = ldg<u32x4>(A1 + 16 * j, offA); b0[j] = ldg<u32x4>(B0 + 16 * j, offA); b1[j] = ldg<u32x4>(B1 + 16 * j, offA); }
        for (int k = 0; k < Kw; k += 32) {
            const int kn = (k + 32 < Kw) ? k + 32 : k;
#pragma unroll
            for (int j = 0; j < 2; ++j) { an0[j] = ldg<u32x4>(A0 + kn + 16 * j, offA); an1[j] = ldg<u32x4>(A1 + kn + 16 * j, offA); bn0[j] = ldg<u32x4>(B0 + kn + 16 * j, offA); bn1[j] = ldg<u32x4>(B1 + kn + 16 * j, offA); }
            FENCE();
#pragma unroll
            for (int j = 0; j < 2; ++j) {
                const bf16x8 fa0 = __builtin_bit_cast(bf16x8, a0[j]), fa1 = __builtin_bit_cast(bf16x8, a1[j]), fb0 = __builtin_bit_cast(bf16x8, b0[j]), fb1 = __builtin_bit_cast(bf16x8, b1[j]);
                c00 = MFMA32(fa0, fb0, c00); c01 = MFMA32(fa0, fb1, c01); c10 = MFMA32(fa1, fb0, c10); c11 = MFMA32(fa1, fb1, c11);
            }
#pragma unroll
            for (int j = 0; j < 2; ++j) { a0[j] = an0[j]; a1[j] = an1[j]; b0[j] = bn0[j]; b1[j] = bn1[j]; }
        }
        __syncthreads();
        LAS float* pl = (LAS float*)(lds + wave * 16384);
#pragma unroll
        for (int i = 0; i < 16; ++i) { const int row = crow(i, hh); pl[row * 64 + r] = c00[i]; pl[row * 64 + 32 + r] = c01[i]; pl[(32 + row) * 64 + r] = c10[i]; pl[(32 + row) * 64 + 32 + r] = c11[i]; }
        __syncthreads();
        const int row = tid >> 3, cb = (tid & 7) * 8;
        f32x4 s0 = *(const LAS f32x4*)(lds + (row * 64 + cb) * 4), s1 = *(const LAS f32x4*)(lds + (row * 64 + cb + 4) * 4);
#pragma unroll
        for (int pq = 1; pq < 8; ++pq) { s0 += *(const LAS f32x4*)(lds + pq * 16384 + (row * 64 + cb) * 4); s1 += *(const LAS f32x4*)(lds + pq * 16384 + (row * 64 + cb + 4) * 4); }
        const size_t off = (size_t)(tm * 64 + row) * D + tn * 64 + cb;
        const f32x4 x0 = *(const f32x4*)(res + off) + s0 * scale, x1 = *(const f32x4*)(res + off + 4) + s1 * scale;
        *(f32x4*)(out + off) = x0; *(f32x4*)(out + off + 4) = x1;
        if (NEXT) {
            u32x4 w; w.x = cvtpk(x0[0], x0[1]); w.y = cvtpk(x0[2], x0[3]); w.z = cvtpk(x1[0], x1[1]); w.w = cvtpk(x1[2], x1[3]);
            *(u32x4*)(xb + off) = w;
            float sq = (x0[0] * x0[0] + x0[1] * x0[1]) + (x0[2] * x0[2] + x0[3] * x0[3]) + (x1[0] * x1[0] + x1[1] * x1[1]) + (x1[2] * x1[2] + x1[3] * x1[3]);
            sq += __shfl_xor(sq, 1); sq += __shfl_xor(sq, 2); sq += __shfl_xor(sq, 4);
            if ((tid & 7) == 0) atomicAdd(ss_out + tm * 64 + row, sq);
        }
    }
    __syncthreads();
}

#define XB_TMO      128
#define XB_XCNT(j)  (256  + 64 * (j))
#define XB_XSUB(j)  (1280 + 64 * (j))
#define XB_XGEN(j)  (2304 + 64 * (j))
#define XB_TOP      3328
#define XB_TOPGEN   3392
#define XCD_BAR_WORDS 3456
#define XB_SPIN_CAP (1u << 22)
DI unsigned xb_ld(unsigned* p)              { return __hip_atomic_load(p, __ATOMIC_RELAXED, __HIP_MEMORY_SCOPE_AGENT); }
DI unsigned xb_add(unsigned* p, unsigned v) { return __hip_atomic_fetch_add(p, v, __ATOMIC_RELAXED, __HIP_MEMORY_SCOPE_AGENT); }
DI unsigned xb_xcc_id() { return (unsigned)__builtin_amdgcn_s_getreg((3 << 11) | 20) & 0xFu; }
#define XB_SPIN(cond, bar) do { unsigned _sp = 0; while (cond) { __builtin_amdgcn_s_sleep(1); \
    if ((++_sp & 255u) == 0u) { if (xb_ld(&(bar)[XB_TMO])) break; if (_sp > XB_SPIN_CAP) { atomicAdd(&(bar)[XB_TMO], 1u); break; } } } } while (0)
struct XcdBarrier { unsigned* bar; unsigned x; volatile LAS unsigned* st; };
DI XcdBarrier xcd_barrier_post(unsigned* bar, volatile LAS unsigned* st) {
    XcdBarrier b; b.bar = bar; b.x = xb_xcc_id(); b.st = st;
    if (threadIdx.x == 0) (void)xb_add(&bar[XB_XCNT(b.x)], 1u);
    return b;
}
DI void xcd_barrier_complete(unsigned* bar, unsigned x, unsigned& nloc, unsigned& nx) {
    const unsigned G = gridDim.x * gridDim.y * gridDim.z;
    unsigned sum, cnt, mine, sp = 0u;
    for (;;) {
        sum = 0u; cnt = 0u; mine = 0u;
#pragma unroll
        for (unsigned j = 0; j < 16; ++j) { const unsigned c = xb_ld(&bar[XB_XCNT(j)]); sum += c; cnt += (c > 0u) ? 1u : 0u; mine = (j == x) ? c : mine; }
        if (sum == G) break;
        __builtin_amdgcn_s_sleep(1);
        if ((++sp & 255u) == 0u) { if (xb_ld(&bar[XB_TMO])) break; if (sp > XB_SPIN_CAP) { atomicAdd(&bar[XB_TMO], 1u); break; } }
    }
    nloc = mine > 0u ? mine : 1u; nx = cnt > 0u ? cnt : 1u;
}
DI void xcd_barrier(const XcdBarrier& b) {
    asm volatile("s_waitcnt vmcnt(0)" ::: "memory");
    __syncthreads();
    if (threadIdx.x == 0) {
        unsigned* bar = b.bar;
        __builtin_amdgcn_s_waitcnt(0);
        unsigned nloc = b.st[0], nx = b.st[1];
        if (nloc == 0u) { xcd_barrier_complete(bar, b.x, nloc, nx); b.st[0] = nloc; b.st[1] = nx; }
        const unsigned old = xb_add(&bar[XB_XSUB(b.x)], 1u);
        const unsigned gen = old / nloc;
        if (old + 1u == (gen + 1u) * nloc) {
            __builtin_amdgcn_fence(__ATOMIC_RELEASE, "agent");
            asm volatile("s_waitcnt vmcnt(0)" ::: "memory");
            const unsigned og = xb_add(&bar[XB_TOP], 1u);
            const unsigned tg = og / nx;
            if (og + 1u == (tg + 1u) * nx) xb_add(&bar[XB_TOPGEN], 1u);
            else XB_SPIN(xb_ld(&bar[XB_TOPGEN]) == tg, bar);
            __builtin_amdgcn_fence(__ATOMIC_ACQUIRE, "agent");
            xb_add(&bar[XB_XGEN(b.x)], 1u);
            asm volatile("s_waitcnt vmcnt(0)" ::: "memory");
        } else {
            XB_SPIN(xb_ld(&bar[XB_XGEN(b.x)]) == gen, bar);
            __builtin_amdgcn_fence(__ATOMIC_ACQUIRE, "agent");
            asm volatile("s_waitcnt vmcnt(0)" ::: "memory");
        }
    }
    __syncthreads();
}

__global__ void __launch_bounds__(512, 2) mega(Params p) {
    extern __shared__ __attribute__((aligned(16))) unsigned char lds_raw[];
    LAS unsigned char* lds = (LAS unsigned char*)lds_raw;
    cg::grid_group grid = cg::this_grid();
    const int tid = threadIdx.x, lane = tid & 63, wave = __builtin_amdgcn_readfirstlane(tid >> 6);
    const int G = gridDim.x, bx = blockIdx.x, gw = bx * 8 + wave, NGW = G * 8;
    unsigned char* ws = p.ws;
    float* ss = (float*)(ws + WS_SS);
    bf16_t* xb = (bf16_t*)(ws + WS_XB);
    bf16_t* gu = (bf16_t*)(ws + WS_GU);
    float* X = p.out + OUT_Y;
    Ctx C; C.in = p.in; C.out = p.out; C.ws = ws;
    C.QT = (bf16_t*)(ws + WS_QT); C.KT = (bf16_t*)(ws + WS_KT); C.KH = (bf16_t*)(ws + WS_KH); C.DEC = (float*)(ws + WS_DEC);
    C.VA = (bf16_t*)(ws + WS_VA); C.GA = (bf16_t*)(ws + WS_GA); C.QB = (bf16_t*)(ws + WS_QB); C.KB = (bf16_t*)(ws + WS_KB); C.VB = (bf16_t*)(ws + WS_VB); C.MIX = (bf16_t*)(ws + WS_MIX);

    volatile LAS unsigned* misc = (volatile LAS unsigned*)(lds + LDS_BYTES - 64);
    if (tid < 2) misc[tid] = 0u;
    if (bx == 0) for (int i = tid; i < XCD_BAR_WORDS; i += 512) ((unsigned*)(ws + WS_BAR))[i] = 0u;
    prologue(p, lds, gw, NGW, wave, lane);
    grid.sync();
    const XcdBarrier xbar = xcd_barrier_post((unsigned*)(ws + WS_BAR), misc);
#define GSYNC() xcd_barrier(xbar)

#define FFN(f, ssin, ssout, resp, ress, NEXTV, CST) do { \
        { pg8::Gemm g{xb, (const bf16_t*)(ws + WS_WGU) + (size_t)(f) * 5632 * 1024, M, 5632, D}; pg8::StaticOrder S; S.init(M, 5632, G, bx); \
          EpiGU E{gu, ss + (size_t)(ssin) * M}; pg8::gemm_phase<EpiGU, pg8::StaticOrder, true, true>(lds, g, S, E); \
          if (CST != 0) { const int rem_ = (132 * 22) % G; if (rem_ != 0 ? bx >= rem_ : true) conv_stage<CST>(p, lds, rem_ != 0 ? bx - rem_ : bx, rem_ != 0 ? G - rem_ : G, wave, lane); } } \
        GSYNC(); \
        { pg8::Gemm g{gu, (const bf16_t*)(ws + WS_WD) + (size_t)(f) * 1024 * DFF, MP, D, DFF}; pg8::StaticOrder S; S.init(MP, D, G, bx); \
          EpiRes<NEXTV> E{resp, ress, X, xb, ss + (size_t)(ssout) * M, 0.5f}; pg8::gemm_phase<EpiRes<NEXTV>, pg8::StaticOrder, true, true>(lds, g, S, E); \
          small_gemm_res<NEXTV>(lds, gu + (size_t)MP * DFF, (const bf16_t*)(ws + WS_WD) + (size_t)(f) * 1024 * DFF, DFF, ress, X + (size_t)MP * D, xb + (size_t)MP * D, ss + (size_t)(ssout) * M + MP, 0.5f, bx, G); } \
        if (NEXTV) GSYNC(); } while (0)

    FFN(0, 0, 1, p.in[0], p.in[1], true, 1);
    {
        pg8::Gemm g{xb, (const bf16_t*)(ws + WS_WIN), M, 7168, D}; pg8::StaticOrder S; S.init(M, 7168, G, bx);
        EpiIn E{ss + (size_t)1 * M, p.in[15], C.QT, C.KT, C.KH, C.DEC, C.VA, p.out + OUT_VP, p.out + OUT_VS};
        pg8::gemm_phase<EpiIn, pg8::StaticOrder, true, true>(lds, g, S, E);
        { const int rem_ = (132 * 28) % G; if (rem_ != 0 ? bx >= rem_ : true) conv_stage<2>(p, lds, rem_ != 0 ? bx - rem_ : bx, rem_ != 0 ? G - rem_ : G, wave, lane); }
    }
    GSYNC();
    {
        LAS unsigned char* wl = wave < 2 ? lds + wave * (2 * HG_BUF) : lds + 2 * (2 * HG_BUF) + (wave - 2) * 16384;
        if (wave < 2) {
            const int id = bx * 2 + wave;
            __builtin_amdgcn_s_setprio(3);
            if (G == 256) {
                const int bh = (bx & 7) + 8 * (bx >> 4), dvs = 2 * ((bx >> 3) & 1) + wave, b = bh >> 3, h = bh & 7;
                hgrn_item(C, wl, lane, (size_t)b * SEQ, SEQ / 32, h, dvs, nullptr, p.out + OUT_HP + (size_t)bh * 16384);
            } else if (id < 512) { const int bh = id >> 2, dvs = id & 3, b = bh >> 3, h = bh & 7;
                hgrn_item(C, wl, lane, (size_t)b * SEQ, SEQ / 32, h, dvs, nullptr, p.out + OUT_HP + (size_t)bh * 16384); }
            __builtin_amdgcn_s_setprio(0);
            for (int sid = id; sid < 1024; sid += 2 * G) { const int bh = sid >> 2, dvs = sid & 3, b = bh >> 3, h = bh & 7;
                hgrn_item(C, wl, lane, (size_t)MP + b * 32, 1, h, dvs, p.in[4] + (size_t)bh * 16384, p.out + OUT_HS + (size_t)bh * 16384); }
        } else {
            if (G == 256) {
                const int x = bx & 7, lw = (bx >> 3) * 6 + (wave - 2);
                for (int j = lw; j < 1024 + 32; j += 192) {
                    if (j < 1024) { const int bh = x + 8 * (j & 15), qb = 63 - (j >> 4); attn_unit<false>(C, wl, lane, bh >> 3, bh & 7, qb); }
                    else { const int v = (j - 1024) * 8 + x; attn_unit<true>(C, wl, lane, v >> 3, v & 7, 0); }
                }
            } else {
            const int aw = bx * 6 + (wave - 2), NAW = G * 6;
            for (int u = aw; u < 8192 + 512; u += NAW) {
                if (u < 8192) { const int bh = u & 127, qb = 63 - (u >> 7); attn_unit<false>(C, wl, lane, bh >> 3, bh & 7, qb); }
                else if (u >= 8192 + 256) { const int v = u - 8192 - 256; attn_unit<true>(C, wl, lane, v >> 3, v & 7, 0); }
            }
            }
        }
    }
    GSYNC();
    {
        const float* gout = p.in[16];
#pragma unroll 2
        for (int m = gw; m < M; m += NGW) {
            bf16_t* mp = C.MIX + (size_t)m * 2048 + 16 * lane; const bf16_t* gp = C.GA + (size_t)m * D + 16 * lane;
            const u32x4 o0 = *(const u32x4*)mp, o1 = *(const u32x4*)(mp + 8), g0 = *(const u32x4*)gp, g1 = *(const u32x4*)(gp + 8);
            float ov[16], gv[16];
#pragma unroll
            for (int e = 0; e < 4; ++e) { ov[2 * e] = bflo(o0[e]); ov[2 * e + 1] = bfhi(o0[e]); ov[8 + 2 * e] = bflo(o1[e]); ov[8 + 2 * e + 1] = bfhi(o1[e]);
                                          gv[2 * e] = bflo(g0[e]); gv[2 * e + 1] = bfhi(g0[e]); gv[8 + 2 * e] = bflo(g1[e]); gv[8 + 2 * e + 1] = bfhi(g1[e]); }
            float sq = 0.f;
#pragma unroll
            for (int e = 0; e < 16; ++e) sq += ov[e] * ov[e];
            sq += __shfl_xor(sq, 1); sq += __shfl_xor(sq, 2); sq += __shfl_xor(sq, 4);
            const float rs = rsqrtf(sq * (1.f / 128.f) + EPS);
            float res[16];
#pragma unroll
            for (int e = 0; e < 16; ++e) res[e] = ov[e] * rs * gout[16 * lane + e] * fsigmoid(gv[e]);
            u32x4 w0, w1;
            w0.x = cvtpk(res[0], res[1]); w0.y = cvtpk(res[2], res[3]); w0.z = cvtpk(res[4], res[5]); w0.w = cvtpk(res[6], res[7]);
            w1.x = cvtpk(res[8], res[9]); w1.y = cvtpk(res[10], res[11]); w1.z = cvtpk(res[12], res[13]); w1.w = cvtpk(res[14], res[15]);
            *(u32x4*)mp = w0; *(u32x4*)(mp + 8) = w1;
        }
    }
    GSYNC();
    {
        pg8::Gemm g{C.MIX, (const bf16_t*)(ws + WS_WOUT), MP, D, 2048}; pg8::StaticOrder S; S.init(MP, D, G, bx);
        EpiRes<true> E{X, X + (size_t)MP * D, X, xb, ss + (size_t)2 * M, 1.0f};
        pg8::gemm_phase<EpiRes<true>, pg8::StaticOrder, true, true>(lds, g, S, E);
        small_gemm_res<true>(lds, C.MIX + (size_t)MP * 2048, (const bf16_t*)(ws + WS_WOUT), 2048, X + (size_t)MP * D, X + (size_t)MP * D, xb + (size_t)MP * D, ss + (size_t)2 * M + MP, 1.0f, bx, G);
    }
    GSYNC();
    FFN(1, 2, 3, X, X + (size_t)MP * D, true, 3);
    FFN(2, 3, 4, X, X + (size_t)MP * D, true, 4);
    {
        pg8::Gemm g{xb, (const bf16_t*)(ws + WS_WCIN), M, 4096, D}; pg8::StaticOrder S; S.init(M, 4096, G, bx);
        EpiCin E{ss + (size_t)4 * M, (bf16_t*)(ws + WS_U), (bf16_t*)(ws + WS_V), (float*)(ws + WS_VST)};
        pg8::gemm_phase<EpiCin, pg8::StaticOrder, true, true>(lds, g, S, E);
    }
    GSYNC();
    {
        LAS unsigned char* wl = lds + wave * 16384;
        for (int u = gw; u < 8192 + 1024; u += NGW) spatial_unit(p, wl, lane, u);
    }
    GSYNC();
    {
        pg8::Gemm g{(const bf16_t*)(ws + WS_GATED), (const bf16_t*)(ws + WS_WCOUT), MP, D, 2048}; pg8::StaticOrder S; S.init(MP, D, G, bx);
        EpiRes<true> E{X, X + (size_t)MP * D, X, xb, ss + (size_t)5 * M, 1.0f};
        pg8::gemm_phase<EpiRes<true>, pg8::StaticOrder, true, true>(lds, g, S, E);
        small_gemm_res<true>(lds, (const bf16_t*)(ws + WS_GATED) + (size_t)MP * 2048, (const bf16_t*)(ws + WS_WCOUT), 2048, X + (size_t)MP * D, X + (size_t)MP * D, xb + (size_t)MP * D, ss + (size_t)5 * M + MP, 1.0f, bx, G);
    }
    GSYNC();
    FFN(3, 5, 5, X, X + (size_t)MP * D, false, 0);
}

extern "C" void kernel_launch(void* const* d_in, const int* in_sizes, int n_in, void* d_out, int out_size, void* d_ws, size_t ws_size, hipStream_t stream) {
    static int grid = 0;
    if (grid == 0) {
        int dev = 0, cus = 0, per_cu = 0;
        (void)hipGetDevice(&dev);
        (void)hipDeviceGetAttribute(&cus, hipDeviceAttributeMultiprocessorCount, dev);
        (void)hipFuncSetAttribute((const void*)mega, hipFuncAttributeMaxDynamicSharedMemorySize, LDS_BYTES);
        (void)hipOccupancyMaxActiveBlocksPerMultiprocessor(&per_cu, (const void*)mega, 512, LDS_BYTES);
        if (per_cu < 1) per_cu = 1;
        grid = cus * per_cu;
        if (n_in != 26 || (size_t)out_size != OUT_TOTAL || ws_size < WS_END) { fprintf(stderr, "kernel_launch: unexpected sizes n_in %d out %d ws %zu\n", n_in, out_size, ws_size); grid = -1; }
    }
    if (grid < 0) return;
    Params p{};
    for (int i = 0; i < 26; ++i) p.in[i] = (const float*)d_in[i];
    p.out = (float*)d_out; p.ws = (unsigned char*)d_ws;
    void* args[] = {&p};
    hipError_t e = hipLaunchCooperativeKernel((const void*)mega, dim3(grid), dim3(512), args, LDS_BYTES, stream);
    if (e != hipSuccess) fprintf(stderr, "cooperative launch failed: %s (grid %d)\n", hipGetErrorString(e), grid);
}
```

```cpp
#include <hip/hip_runtime.h>
#include <hip/hip_cooperative_groups.h>
#include <cstdio>
#include <cstdint>
namespace cg = cooperative_groups;

#define DI __device__ __forceinline__
#define LAS __attribute__((address_space(3)))
typedef unsigned short bf16_t;
typedef short bf16x8 __attribute__((ext_vector_type(8)));
typedef short s16x4 __attribute__((ext_vector_type(4)));
typedef float f32x4 __attribute__((ext_vector_type(4)));
typedef float f32x16 __attribute__((ext_vector_type(16)));
typedef unsigned u32x4 __attribute__((ext_vector_type(4)));
typedef unsigned u32x2 __attribute__((ext_vector_type(2)));
typedef float f32x2_t __attribute__((ext_vector_type(2)));
typedef __bf16 bf16x2_t __attribute__((ext_vector_type(2)));
typedef short v4i16_t __attribute__((ext_vector_type(4)));

constexpr int D = 1024, DFF = 2816, MP = 32768, MS = 1024, M = MP + MS, SEQ = 2048, TS = 32;
constexpr float EPS = 1e-6f;
constexpr size_t OUT_Y = 0, OUT_KP = 34603008, OUT_VP = 68157440, OUT_HP = 101711872, OUT_KS = 103809024, OUT_VS = 104857600,
                 OUT_HS = 105906176, OUT_GV = 110100480, OUT_TOTAL = 112197632;
constexpr size_t MiB = 1u << 20;
constexpr size_t SZB = (size_t)M * 1024 * 2;
constexpr size_t WS_WGU = 0;
constexpr size_t WS_WD = 44 * MiB;
constexpr size_t WS_WIN = 66 * MiB;
constexpr size_t WS_WOUT = 80 * MiB;
constexpr size_t WS_WCIN = 84 * MiB;
constexpr size_t WS_WCOUT = 92 * MiB;
constexpr size_t WS_SS = 96 * MiB;
constexpr size_t WS_VST = WS_SS + (size_t)6 * M * 4;
constexpr size_t WS_BAR = 97 * MiB + 512 * 1024;
constexpr size_t WS_XB = 98 * MiB;
constexpr size_t WS_R = 164 * MiB;
constexpr size_t WS_GU = WS_R;
constexpr size_t WS_QT = WS_R, WS_KT = WS_QT + SZB, WS_KH = WS_KT + SZB, WS_DEC = WS_KH + SZB;
constexpr size_t WS_VA = WS_DEC + 5 * MiB, WS_GA = WS_VA + SZB, WS_QB = WS_GA + SZB, WS_KB = WS_QB + SZB, WS_VB = WS_KB + SZB;
constexpr size_t WS_MIX = WS_VB + SZB;
constexpr size_t WS_U = WS_R, WS_V = WS_U + 2 * SZB, WS_GATED = WS_V + 2 * SZB;
constexpr size_t WS_END = WS_MIX + 2 * SZB;
static_assert(WS_VST + (size_t)M * 8 <= WS_XB && WS_GATED + 2 * SZB <= WS_END && WS_GU + (size_t)M * DFF * 2 <= WS_END, "ws map");

constexpr int LDS_BYTES = 147456;

struct Params { const float* in[26]; float* out; unsigned char* ws; };

DI unsigned cvtpk(float lo, float hi) { f32x2_t v = {lo, hi}; bf16x2_t b = __builtin_convertvector(v, bf16x2_t); return __builtin_bit_cast(unsigned, b); }
DI float bflo(unsigned u) { return __uint_as_float(u << 16); }
DI float bfhi(unsigned u) { return __uint_as_float(u & 0xffff0000u); }
DI float bf2f(bf16_t b) { return __uint_as_float((unsigned)b << 16); }
DI bf16_t f2bf(float f) { return (bf16_t)(cvtpk(f, 0.f) & 0xffffu); }
DI float fsigmoid(float x) { return __fdividef(1.f, 1.f + __expf(-x)); }
DI float fsilu(float x) { return __fdividef(x, 1.f + __expf(-x)); }
DI float fgelu(float x) { const float u2 = 1.5957691216057308f * (x + 0.044715f * x * x * x); return __fdividef(x, 1.f + __expf(-u2)); }
DI int crow(int reg, int h) { return (reg & 3) + 8 * (reg >> 2) + 4 * h; }
DI float wave_sum(float v) {
#pragma unroll
    for (int o = 1; o < 64; o <<= 1) v += __shfl_xor(v, o);
    return v;
}
DI bf16x8 pack8(const f32x16& x, int s) {
    u32x4 p; p.x = cvtpk(x[8 * s], x[8 * s + 1]); p.y = cvtpk(x[8 * s + 2], x[8 * s + 3]); p.z = cvtpk(x[8 * s + 4], x[8 * s + 5]); p.w = cvtpk(x[8 * s + 6], x[8 * s + 7]);
    return __builtin_bit_cast(bf16x8, p);
}
DI bf16x8 pack8f(f32x4 a, f32x4 b) { u32x4 p; p.x = cvtpk(a[0], a[1]); p.y = cvtpk(a[2], a[3]); p.z = cvtpk(b[0], b[1]); p.w = cvtpk(b[2], b[3]); return __builtin_bit_cast(bf16x8, p); }
DI s16x4 vtr(LAS const unsigned char* p) { return __builtin_bit_cast(s16x4, __builtin_amdgcn_ds_read_tr16_b64_v4i16((LAS v4i16_t*)p)); }
DI bf16x8 cat8(s16x4 lo, s16x4 hi) { return __builtin_shufflevector(lo, hi, 0, 1, 2, 3, 4, 5, 6, 7); }
#define FENCE() asm volatile("" ::: "memory")
#define MFMA32(a, b, c) __builtin_amdgcn_mfma_f32_32x32x16_bf16((a), (b), (c), 0, 0, 0)

namespace pg8 {
constexpr int BM = 256, BK = 64, HALF = 128, HTB = HALF * BK * 2, STAGE_BYTES = 8 * HTB, NXCD = 8, WGM = 8;
DI int lds_byte(int r, int c) { const int st = (r >> 4) * 2 + (c >> 5), rr = r & 15, cc = c & 31, ob = rr * 64 + cc * 2; return st * 1024 + (ob ^ (((ob >> 9) & 1) << 5)); }
DI void stage_rc(int b, int& R, int& C) { const int st = b / 1024, sb = b % 1024, swz = sb ^ (((sb >> 9) & 1) << 5); R = (st >> 1) * 16 + swz / 64; C = (st & 1) * 32 + (swz % 64) / 2; }
DI int perm32(int rho) { const int n = rho >> 4, i = rho & 15; return 8 * (i >> 2) + 4 * n + (i & 3); }
struct Unit { int pm, pn; };
struct Gemm { const bf16_t* A; const bf16_t* Bt; int M, N, K; };
struct StaticOrder {
    int nM, nN, nwg, G, c;
    DI void init(int M_, int N_, int G_, int c_) { nM = M_ / BM; nN = N_ / BM; nwg = nM * nN; G = G_; c = c_; }
    DI bool next(int i, Unit& u) const {
        const long L = (long)i * G + c; if (L >= nwg) return false;
        int wgid = (int)L; { const int q = nwg / NXCD, r = nwg % NXCD, xcd = wgid % NXCD, off = wgid / NXCD; wgid = (xcd < r ? xcd * (q + 1) : r * (q + 1) + (xcd - r) * q) + off; }
        const int nig = WGM * nN, gid = wgid / nig, fm = gid * WGM, gsz = (nM - fm) < WGM ? (nM - fm) : WGM;
        u.pm = fm + ((wgid % nig) % gsz); u.pn = (wgid % nig) / gsz; return true;
    }
    DI void a_ready(const Unit&) const {}
    DI void done(const Unit&) const {}
};
template <class Epi, class Sched, bool ALIGN_EPI = false, bool SP2 = false>
DI void gemm_phase(LAS unsigned char* lds, const Gemm g, const Sched& S, const Epi& E) {
    int tid_ = threadIdx.x; asm volatile("" : "+v"(tid_));
    const int tid = tid_, wid = __builtin_amdgcn_readfirstlane(tid >> 6), lane = tid & 63, wr = wid >> 2, wc = wid & 3, fr = lane & 15, fq = lane >> 4;
    const int K = g.K, nt = K / BK;
    unsigned voffA[2], voffB[2];
#pragma unroll
    for (int i = 0; i < 2; ++i) { int R, C; stage_rc(tid * 16 + i * 8192, R, C); const int Rb = Epi::PERM ? ((R & ~31) + perm32(R & 31)) : R;
        voffA[i] = (unsigned)(R * K + C) * 2u; voffB[i] = (unsigned)(Rb * K + C) * 2u; }
    const size_t kstep = (size_t)(BK * 2);
    const size_t hstep = (size_t)HALF * K * 2;
    const size_t tstep = 2 * hstep;
    const unsigned ldsw = (unsigned)wid * 1024u;
    const int aoff = lds_byte(wr * 64 + fr, fq * 8), boff = lds_byte(wc * 32 + fr, fq * 8);
#define PG8_SA(b, h) (((b) * 2 + (h)) * HTB)
#define PG8_SB(b, h) ((4 + (b) * 2 + (h)) * HTB)
#define PG8_STAGE(bufoff, gbase, voff) do { _Pragma("unroll") for (int _i = 0; _i < 2; ++_i) \
        __builtin_amdgcn_global_load_lds((const unsigned*)((const char*)(gbase) + (voff)[_i]), (LAS unsigned*)(lds + (bufoff) + ldsw + _i * 8192), 16, 0, 0); } while (0)
#define PG8_LDA(dst, b, h) do { _Pragma("unroll") for (int m = 0; m < 4; ++m) _Pragma("unroll") for (int k = 0; k < 2; ++k) dst[m][k] = *(const LAS bf16x8*)(lds + PG8_SA(b, h) + aoff + m * 2048 + k * 1024); } while (0)
#define PG8_LDB(dst, b, h) do { _Pragma("unroll") for (int n = 0; n < 2; ++n) _Pragma("unroll") for (int k = 0; k < 2; ++k) dst[n][k] = *(const LAS bf16x8*)(lds + PG8_SB(b, h) + boff + n * 2048 + k * 1024); } while (0)
#define PG8_MMA(ai, bj, At, Bt) do { __builtin_amdgcn_s_setprio(1); _Pragma("unroll") for (int m = 0; m < 4; ++m) _Pragma("unroll") for (int n = 0; n < 2; ++n) _Pragma("unroll") for (int k = 0; k < 2; ++k) \
        acc[ai][bj][m][n] = __builtin_amdgcn_mfma_f32_16x16x32_bf16(Bt[n][k], At[m][k], acc[ai][bj][m][n], 0, 0, 0); __builtin_amdgcn_s_setprio(0); } while (0)
#define PG8_WAIT_V(n) asm volatile("s_waitcnt vmcnt(" #n ")" ::: "memory")
#define PG8_WAIT_L(n) asm volatile("s_waitcnt lgkmcnt(" #n ")" ::: "memory")
#define PG8_BAR __builtin_amdgcn_s_barrier()
#define PG8_SCHED __builtin_amdgcn_sched_barrier(0)
    Unit cur, nxt; int ui = 0;
    if (!S.next(0, cur)) return;
    f32x4 acc[2][2][4][2];
#pragma unroll
    for (int a = 0; a < 2; ++a)
#pragma unroll
        for (int b = 0; b < 2; ++b)
#pragma unroll
            for (int m = 0; m < 4; ++m)
#pragma unroll
                for (int n = 0; n < 2; ++n) acc[a][b][m][n] = (f32x4){0.f, 0.f, 0.f, 0.f};
    bf16x8 At[4][2], B0[2][2], B1[2][2];
    const char* cA = (const char*)g.A + (size_t)cur.pm * tstep; const char* cB = (const char*)g.Bt + (size_t)cur.pn * tstep;
    S.a_ready(cur);
    if constexpr (SP2) {
        PG8_STAGE(PG8_SB(0, 0), cB, voffB); PG8_STAGE(PG8_SB(0, 1), cB + hstep, voffB); PG8_STAGE(PG8_SA(0, 0), cA, voffA); PG8_STAGE(PG8_SA(0, 1), cA + hstep, voffA);
        if (wr == 1) PG8_BAR;
        PG8_WAIT_V(2); PG8_BAR;
        PG8_STAGE(PG8_SB(1, 0), cB + kstep, voffB); PG8_STAGE(PG8_SA(1, 0), cA + kstep, voffA); PG8_STAGE(PG8_SB(1, 1), cB + hstep + kstep, voffB);
        PG8_WAIT_V(6); PG8_BAR;
    } else {
        PG8_STAGE(PG8_SB(0, 0), cB, voffB); PG8_STAGE(PG8_SA(0, 0), cA, voffA); PG8_STAGE(PG8_SB(0, 1), cB + hstep, voffB); PG8_STAGE(PG8_SA(0, 1), cA + hstep, voffA);
        if (wr == 1) PG8_BAR;
        PG8_WAIT_V(4); PG8_BAR;
        PG8_STAGE(PG8_SB(1, 0), cB + kstep, voffB); PG8_STAGE(PG8_SA(1, 0), cA + kstep, voffA); PG8_STAGE(PG8_SB(1, 1), cB + hstep + kstep, voffB);
        PG8_WAIT_V(6); PG8_BAR;
    }
    for (;;) {
        const bool has_next = S.next(ui + 1, nxt);
        const char* nA = has_next ? (const char*)g.A + (size_t)nxt.pm * tstep : cA; const char* nB = has_next ? (const char*)g.Bt + (size_t)nxt.pn * tstep : cB;
        for (int t = 0; t < nt; t += 2) {
            const bool last = (t == nt - 2);
            const char* a1 = cA + (size_t)(t + 1) * kstep;
            const char* a2 = last ? nA : cA + (size_t)(t + 2) * kstep; const char* b2 = last ? nB : cB + (size_t)(t + 2) * kstep;
            const char* a3 = a2 + kstep; const char* b3 = b2 + kstep;
            if (last && has_next) S.a_ready(nxt);
            if constexpr (SP2) {
            PG8_LDB(B0, 0, 0); PG8_LDB(B1, 0, 1); PG8_SCHED; PG8_LDA(At, 0, 0); PG8_STAGE(PG8_SA(1, 1), a1 + hstep, voffA);
            PG8_WAIT_V(8); PG8_WAIT_L(0); PG8_BAR; PG8_MMA(0, 0, At, B0); PG8_MMA(0, 1, At, B1); PG8_BAR; PG8_SCHED;
            PG8_LDA(At, 0, 1); PG8_STAGE(PG8_SB(0, 0), b2, voffB); PG8_STAGE(PG8_SB(0, 1), b2 + hstep, voffB); PG8_STAGE(PG8_SA(0, 0), a2, voffA);
            PG8_WAIT_V(8); PG8_WAIT_L(0); PG8_BAR; PG8_MMA(1, 0, At, B0); PG8_MMA(1, 1, At, B1); PG8_BAR; PG8_SCHED;
            PG8_LDB(B0, 1, 0); PG8_LDB(B1, 1, 1); PG8_SCHED; PG8_LDA(At, 1, 0); PG8_STAGE(PG8_SA(0, 1), a2 + hstep, voffA);
            PG8_WAIT_V(8); PG8_WAIT_L(0); PG8_BAR; PG8_MMA(0, 0, At, B0); PG8_MMA(0, 1, At, B1); PG8_BAR; PG8_SCHED;
            PG8_LDA(At, 1, 1); PG8_STAGE(PG8_SB(1, 0), b3, voffB); PG8_STAGE(PG8_SB(1, 1), b3 + hstep, voffB); PG8_STAGE(PG8_SA(1, 0), a3, voffA);
            PG8_WAIT_V(8); PG8_WAIT_L(0); PG8_BAR; PG8_MMA(1, 0, At, B0); PG8_MMA(1, 1, At, B1); PG8_BAR; PG8_SCHED;
            } else {
            PG8_LDB(B0, 0, 0); PG8_SCHED; PG8_LDA(At, 0, 0); PG8_STAGE(PG8_SA(1, 1), a1 + hstep, voffA);
            PG8_WAIT_L(8); PG8_BAR; PG8_WAIT_L(0); PG8_MMA(0, 0, At, B0); PG8_BAR; PG8_SCHED;
            PG8_LDB(B1, 0, 1); PG8_STAGE(PG8_SB(0, 0), b2, voffB);
            PG8_BAR; PG8_WAIT_L(0); PG8_MMA(0, 1, At, B1); PG8_BAR;
            PG8_LDA(At, 0, 1); PG8_STAGE(PG8_SA(0, 0), a2, voffA);
            PG8_BAR; PG8_WAIT_L(0); PG8_MMA(1, 0, At, B0); PG8_BAR; PG8_SCHED;
            PG8_STAGE(PG8_SB(0, 1), b2 + hstep, voffB);
            PG8_WAIT_V(6); PG8_BAR; PG8_MMA(1, 1, At, B1); PG8_BAR;
            PG8_LDB(B0, 1, 0); PG8_SCHED; PG8_LDA(At, 1, 0); PG8_STAGE(PG8_SA(0, 1), a2 + hstep, voffA);
            PG8_WAIT_L(8); PG8_BAR; PG8_WAIT_L(0); PG8_MMA(0, 0, At, B0); PG8_BAR; PG8_SCHED;
            PG8_LDB(B1, 1, 1); PG8_STAGE(PG8_SB(1, 0), b3, voffB);
            PG8_BAR; PG8_WAIT_L(0); PG8_MMA(0, 1, At, B1); PG8_BAR;
            PG8_LDA(At, 1, 1); PG8_STAGE(PG8_SA(1, 0), a3, voffA);
            PG8_BAR; PG8_WAIT_L(0); PG8_MMA(1, 0, At, B0); PG8_BAR; PG8_SCHED;
            PG8_STAGE(PG8_SB(1, 1), b3 + hstep, voffB);
            PG8_WAIT_V(6); PG8_BAR; PG8_MMA(1, 1, At, B1); PG8_BAR;
            }
        }
        if constexpr (ALIGN_EPI) { if (wr == 0) PG8_BAR; }
        E(acc, cur, wr, wc, fr, fq); S.done(cur);
        if (!has_next) break;
#pragma unroll
        for (int a = 0; a < 2; ++a)
#pragma unroll
            for (int b = 0; b < 2; ++b)
#pragma unroll
                for (int m = 0; m < 4; ++m)
#pragma unroll
                    for (int n = 0; n < 2; ++n) acc[a][b][m][n] = (f32x4){0.f, 0.f, 0.f, 0.f};
        cur = nxt; cA = nA; cB = nB; ++ui;
        if constexpr (ALIGN_EPI) { if (wr == 1) PG8_BAR; }
    }
    PG8_WAIT_V(0);
    if constexpr (!ALIGN_EPI) { if (wr == 0) PG8_BAR; }
    PG8_BAR;
#undef PG8_SA
#undef PG8_SB
#undef PG8_STAGE
#undef PG8_LDA
#undef PG8_LDB
#undef PG8_MMA
#undef PG8_WAIT_V
#undef PG8_WAIT_L
#undef PG8_BAR
#undef PG8_SCHED
}
}
using pg8::Unit;

DI float rstd_row(const float* ss, int row) { return rsqrtf(ss[row] * (1.f / 1024.f) + EPS); }

struct EpiGU {
    static constexpr bool PERM = true;
    bf16_t* O; const float* ss;
    DI void operator()(const f32x4 (&acc)[2][2][4][2], const Unit& u, int wr, int wc, int fr, int fq) const {
        const int row0 = u.pm * 256 + wr * 64 + fr, col0 = u.pn * 128 + wc * 32 + 8 * fq;
#pragma unroll
        for (int ai = 0; ai < 2; ++ai)
#pragma unroll
            for (int m = 0; m < 4; ++m) {
                const int row = row0 + ai * 128 + m * 16; const float r = rstd_row(ss, row);
                float o[8];
#pragma unroll
                for (int n = 0; n < 2; ++n)
#pragma unroll
                    for (int e = 0; e < 4; ++e) { const float g = acc[ai][0][m][n][e] * r, up = acc[ai][1][m][n][e] * r; o[4 * n + e] = fsilu(g) * up; }
                u32x4 w; w.x = cvtpk(o[0], o[1]); w.y = cvtpk(o[2], o[3]); w.z = cvtpk(o[4], o[5]); w.w = cvtpk(o[6], o[7]);
                *(u32x4*)(O + (size_t)row * DFF + col0) = w;
            }
    }
};
template <bool NEXT> struct EpiRes {
    static constexpr bool PERM = false;
    const float* res_p; const float* res_s; float* out; bf16_t* xb; float* ss_out; float scale;
    DI void operator()(const f32x4 (&acc)[2][2][4][2], const Unit& u, int wr, int wc, int fr, int fq) const {
        const int row0 = u.pm * 256 + wr * 64 + fr, col0 = u.pn * 256 + wc * 32 + 4 * fq;
        const bool smp = u.pm >= 128;
#pragma unroll
        for (int ai = 0; ai < 2; ++ai)
#pragma unroll
            for (int m = 0; m < 4; ++m) {
                const int row = row0 + ai * 128 + m * 16;
                const float* rb = smp ? res_s + (size_t)(row - MP) * D : res_p + (size_t)row * D;
                float sq = 0.f;
#pragma unroll
                for (int bj = 0; bj < 2; ++bj)
#pragma unroll
                    for (int n = 0; n < 2; ++n) {
                        const int col = col0 + bj * 128 + n * 16;
                        const f32x4 b = *(const f32x4*)(rb + col);
                        const f32x4 x = b + acc[ai][bj][m][n] * scale;
                        *(f32x4*)(out + (size_t)row * D + col) = x;
                        if (NEXT) { u32x2 w; w.x = cvtpk(x[0], x[1]); w.y = cvtpk(x[2], x[3]); *(u32x2*)(xb + (size_t)row * D + col) = w;
                                    sq += (x[0] * x[0] + x[1] * x[1]) + (x[2] * x[2] + x[3] * x[3]); }
                    }
                if (NEXT) { sq += __shfl_xor(sq, 16); sq += __shfl_xor(sq, 32); if (fq == 0) atomicAdd(ss_out + row, sq); }
            }
    }
};
struct EpiIn {
    static constexpr bool PERM = true;
    const float* ss; const float* lbp;
    bf16_t *QT, *KT, *KH; float* DEC; bf16_t* SEG;
    float* outv_p; float* outv_s;
    DI void operator()(const f32x4 (&acc)[2][2][4][2], const Unit& u, int wr, int wc, int fr, int fq) const {
        const int row0 = u.pm * 256 + wr * 64 + fr;
        if (u.pn < 8) {
            const int chb = u.pn * 128 + wc * 32 + 8 * fq;
#pragma unroll
            for (int n = 0; n < 2; ++n) {
                const int ch = chb + 4 * n;
                const f32x4 a0 = *(const f32x4*)(lbp + ch), a1 = *(const f32x4*)(lbp + 1024 + ch);
                float lb[4];
#pragma unroll
                for (int e = 0; e < 4; ++e) lb[e] = __fdividef(1.f, 1.f + __expf(a1[e] - a0[e]));
#pragma unroll
                for (int ai = 0; ai < 2; ++ai)
#pragma unroll
                    for (int mm = 0; mm < 2; ++mm) {
                        const int R0 = row0 + ai * 128 + mm * 32, R1 = R0 + 16;
                        const float r0 = rstd_row(ss, R0), r1 = rstd_row(ss, R1);
                        float qt0[4], kt0[4], kh0[4], qt1[4], kt1[4], kh1[4], dc[4];
#pragma unroll
                        for (int e = 0; e < 4; ++e) {
                            const float f0 = lb[e] + (1.f - lb[e]) * fsigmoid(acc[ai][1][2 * mm][n][e] * r0);
                            const float f1 = lb[e] + (1.f - lb[e]) * fsigmoid(acc[ai][1][2 * mm + 1][n][e] * r1);
                            float p0 = __logf(f0), p1 = __logf(f1);
#pragma unroll
                            for (int d = 1; d < 16; d <<= 1) { const float t0 = __shfl_up(p0, d, 16), t1 = __shfl_up(p1, d, 16); if (fr >= d) { p0 += t0; p1 += t1; } }
                            const float tot0 = __shfl(p0, 15, 16);
                            p1 += tot0;
                            const float cl = __shfl(p1, 15, 16);
                            const float q0 = fsilu(acc[ai][0][2 * mm][n][e] * r0), q1 = fsilu(acc[ai][0][2 * mm + 1][n][e] * r1);
                            const float k0 = 1.f - f0, k1 = 1.f - f1;
                            qt0[e] = q0 * __expf(p0); kt0[e] = k0 * __expf(-p0); kh0[e] = k0 * __expf(cl - p0);
                            qt1[e] = q1 * __expf(p1); kt1[e] = k1 * __expf(-p1); kh1[e] = k1 * __expf(cl - p1);
                            dc[e] = __expf(cl);
                        }
                        const int cw = ch & 127;
                        const size_t f0 = ((size_t)(R0 >> 5) * 8 + u.pn) * 4096 + (size_t)(((cw >> 4) * 64 + ((cw >> 2) & 1) * 32 + (R0 & 31)) * 8 + ((cw >> 3) & 1) * 4);
                        const size_t f1 = f0 + 16 * 8;
                        u32x2 w;
                        w.x = cvtpk(qt0[0], qt0[1]); w.y = cvtpk(qt0[2], qt0[3]); *(u32x2*)(QT + f0) = w;
                        w.x = cvtpk(kt0[0], kt0[1]); w.y = cvtpk(kt0[2], kt0[3]); *(u32x2*)(KT + f0) = w;
                        w.x = cvtpk(kh0[0], kh0[1]); w.y = cvtpk(kh0[2], kh0[3]); *(u32x2*)(KH + (size_t)R0 * D + ch) = w;
                        w.x = cvtpk(qt1[0], qt1[1]); w.y = cvtpk(qt1[2], qt1[3]); *(u32x2*)(QT + f1) = w;
                        w.x = cvtpk(kt1[0], kt1[1]); w.y = cvtpk(kt1[2], kt1[3]); *(u32x2*)(KT + f1) = w;
                        w.x = cvtpk(kh1[0], kh1[1]); w.y = cvtpk(kh1[2], kh1[3]); *(u32x2*)(KH + (size_t)R1 * D + ch) = w;
                        if (fr == 15) *(f32x4*)(DEC + (size_t)(R1 >> 5) * D + ch) = (f32x4){dc[0], dc[1], dc[2], dc[3]};
                    }
            }
        } else {
            const int seg = (u.pn >> 2) - 2;
            bf16_t* base = SEG + (size_t)seg * (SZB / 2);
            const int col0 = (u.pn & 3) * 256 + wc * 32 + 8 * fq;
            const bool isv = seg == 4, isqk = seg == 2 || seg == 3; const bool smp = u.pm >= 128;
#pragma unroll
            for (int ai = 0; ai < 2; ++ai)
#pragma unroll
                for (int m = 0; m < 4; ++m) {
                    const int row = row0 + ai * 128 + m * 16; const float r = rstd_row(ss, row);
#pragma unroll
                    for (int bj = 0; bj < 2; ++bj) {
                        const f32x4 v0 = acc[ai][bj][m][0] * r, v1 = acc[ai][bj][m][1] * r;
                        u32x4 w; w.x = cvtpk(v0[0], v0[1]); w.y = cvtpk(v0[2], v0[3]); w.z = cvtpk(v1[0], v1[1]); w.w = cvtpk(v1[2], v1[3]);
                        const int col = col0 + bj * 128;
                        if (isqk) *(u32x4*)(base + ((size_t)(row >> 5) * 8 + (col >> 7)) * 4096 + (size_t)((((col & 127) >> 4) * 64 + ((col >> 3) & 1) * 32 + (row & 31)) * 8)) = w;
                        else *(u32x4*)(base + (size_t)row * D + col) = w;
                        if (isv) { float* o = (smp ? outv_s + (size_t)(row - MP) * D : outv_p + (size_t)row * D) + col0 + bj * 128;
                                   *(f32x4*)o = v0; *(f32x4*)(o + 4) = v1; }
                    }
                }
        }
    }
};
struct EpiCin {
    static constexpr bool PERM = true;
    const float* ss; bf16_t* U; bf16_t* V; float* vst;
    DI void operator()(const f32x4 (&acc)[2][2][4][2], const Unit& u, int wr, int wc, int fr, int fq) const {
        const int row0 = u.pm * 256 + wr * 64 + fr;
        const bool isv = u.pn >= 8;
        bf16_t* base = isv ? V : U;
        const int col0 = (u.pn & 7) * 256 + wc * 32 + 8 * fq;
#pragma unroll
        for (int ai = 0; ai < 2; ++ai)
#pragma unroll
            for (int m = 0; m < 4; ++m) {
                const int row = row0 + ai * 128 + m * 16; const float r = rstd_row(ss, row);
                float s1 = 0.f, s2 = 0.f;
#pragma unroll
                for (int bj = 0; bj < 2; ++bj) {
                    float o[8];
#pragma unroll
                    for (int n = 0; n < 2; ++n)
#pragma unroll
                        for (int e = 0; e < 4; ++e) { const float v = fgelu(acc[ai][bj][m][n][e] * r); o[4 * n + e] = v; s1 += v; s2 += v * v; }
                    u32x4 w; w.x = cvtpk(o[0], o[1]); w.y = cvtpk(o[2], o[3]); w.z = cvtpk(o[4], o[5]); w.w = cvtpk(o[6], o[7]);
                    *(u32x4*)(base + (size_t)row * 2048 + col0 + bj * 128) = w;
                }
                if (isv) { s1 += __shfl_xor(s1, 16); s1 += __shfl_xor(s1, 32); s2 += __shfl_xor(s2, 16); s2 += __shfl_xor(s2, 32);
                           if (fq == 0) { atomicAdd(vst + 2 * row, s1); atomicAdd(vst + 2 * row + 1, s2); } }
            }
    }
};

struct Ctx {
    const float* const* in; float* out; unsigned char* ws;
    bf16_t *QT, *KT, *KH, *VA, *GA, *QB, *KB, *VB, *MIX; float* DEC;
};

DI void transpose_item(const float* W, int N, int K, bf16_t* WT, int drow0, int k0, int n0, const float* gain, LAS float* scr, int lane) {
    const int c4 = (lane & 15) * 4, kr = lane >> 4;
#pragma unroll 4
    for (int i = 0; i < 16; ++i) { const int kk = 4 * i + kr; f32x4 v = *(const f32x4*)(W + (size_t)(k0 + kk) * N + n0 + c4); if (gain) v *= gain[k0 + kk];
        LAS float* d = scr + kk * 65 + c4; d[0] = v[0]; d[1] = v[1]; d[2] = v[2]; d[3] = v[3]; }
    asm volatile("s_waitcnt lgkmcnt(0)" ::: "memory");
    const int c = lane & 7;
#pragma unroll
    for (int j = 0; j < 8; ++j) { const int n = (lane >> 3) + 8 * j; const LAS float* sp = scr + (8 * c) * 65 + n;
        u32x4 o; o.x = cvtpk(sp[0 * 65], sp[1 * 65]); o.y = cvtpk(sp[2 * 65], sp[3 * 65]); o.z = cvtpk(sp[4 * 65], sp[5 * 65]); o.w = cvtpk(sp[6 * 65], sp[7 * 65]);
        *(u32x4*)(WT + (size_t)(drow0 + n) * K + k0 + 8 * c) = o; }
    asm volatile("s_waitcnt lgkmcnt(0)" ::: "memory");
}
constexpr int CV_GU = 16 * 44, CV_D = 44 * 16, CV_IN = 16 * 112, CV_O = 32 * 16, CV_CI = 16 * 64;
constexpr int CV_D0 = 8 * CV_GU, CV_W0 = CV_D0 + 4 * CV_D, CV_END = CV_W0 + CV_IN + CV_O + CV_CI + CV_O;
DI void conv_items(const Params& p, LAS unsigned char* lds, int lo0, int hi0, int lo1, int hi1, int lo2, int hi2, int rank, int nranks, int wave, int lane) {
    LAS float* scr = (LAS float*)(lds + wave * 18432);
    unsigned char* ws = p.ws;
    constexpr int I_GU = 16 * 44, I_D = 44 * 16, I_IN = 16 * 112, I_O = 32 * 16, I_CI = 16 * 64;
    constexpr int NITEMS = 8 * I_GU + 4 * I_D + I_IN + I_O + I_CI + I_O;
    (void)NITEMS;
    const int n0_ = hi0 - lo0, n1_ = hi1 - lo1, n2_ = hi2 - lo2;
    for (int it = rank; it < n0_ + n1_ + n2_; it += nranks) {
        int r = it < n0_ ? lo0 + it : (it < n0_ + n1_ ? lo1 + (it - n0_) : lo2 + (it - n0_ - n1_));
        if (r < 8 * I_GU) {
            const int mat = r / I_GU, item = r % I_GU, f = mat >> 1, up = mat & 1, l = f >> 1, second = f & 1;
            const float* W = p.in[second ? (up ? 12 : 11) : (up ? 7 : 6)] + (size_t)l * D * DFF;
            const float* gain = p.in[second ? 10 : 5] + l * D;
            const int kb = item / 44, nb = item % 44, n0 = nb * 64;
            const int drow0 = (n0 >> 7) * 256 + up * 128 + (n0 & 127);
            transpose_item(W, DFF, D, (bf16_t*)(ws + WS_WGU) + (size_t)f * 5632 * 1024, drow0, kb * 64, n0, gain, scr, lane);
            continue;
        }
        r -= 8 * I_GU;
        if (r < 4 * I_D) {
            const int f = r / I_D, item = r % I_D, l = f >> 1, second = f & 1;
            const float* W = p.in[second ? 13 : 8] + (size_t)l * DFF * D;
            const int kb = item / 16, nb = item % 16;
            transpose_item(W, D, DFF, (bf16_t*)(ws + WS_WD) + (size_t)f * 1024 * DFF, nb * 64, kb * 64, nb * 64, nullptr, scr, lane);
            continue;
        }
        r -= 4 * I_D;
        if (r < I_IN) {
            const int kb = r / 112, nb = r % 112, n0 = nb * 64, seg = n0 >> 10, w = n0 & 1023;
            const int drow0 = seg == 0 ? (w >> 7) * 256 + (w & 127) : (seg == 1 ? (w >> 7) * 256 + 128 + (w & 127) : n0);
            transpose_item(p.in[14], 7168, D, (bf16_t*)(ws + WS_WIN), drow0, kb * 64, n0, p.in[9], scr, lane);
            continue;
        }
        r -= I_IN;
        if (r < I_O) { const int kb = r / 16, nb = r % 16; transpose_item(p.in[19], D, 2048, (bf16_t*)(ws + WS_WOUT), nb * 64, kb * 64, nb * 64, nullptr, scr, lane); continue; }
        r -= I_O;
        if (r < I_CI) { const int kb = r / 64, nb = r % 64; transpose_item(p.in[20], 4096, D, (bf16_t*)(ws + WS_WCIN), nb * 64, kb * 64, nb * 64, p.in[9] + D, scr, lane); continue; }
        r -= I_CI;
        { const int kb = r / 16, nb = r % 16; transpose_item(p.in[25], D, 2048, (bf16_t*)(ws + WS_WCOUT), nb * 64, kb * 64, nb * 64, nullptr, scr, lane); }
    }
}
DI void prologue(const Params& p, LAS unsigned char* lds, int gw, int NGW, int wave, int lane) {
    unsigned char* ws = p.ws;
    conv_items(p, lds, 0, 2 * CV_GU, 0, 0, 0, 0, gw, NGW, wave, lane);
    float* ss = (float*)(ws + WS_SS);
    bf16_t* xb = (bf16_t*)(ws + WS_XB);
#pragma unroll 2
    for (int m = gw; m < M; m += NGW) {
        const float* xr = (m < MP) ? p.in[0] + (size_t)m * D : p.in[1] + (size_t)(m - MP) * D;
        float s = 0.f;
#pragma unroll
        for (int j = 0; j < 4; ++j) { const f32x4 v = *(const f32x4*)(xr + 4 * lane + 256 * j); s += (v[0] * v[0] + v[1] * v[1]) + (v[2] * v[2] + v[3] * v[3]);
            u32x2 w; w.x = cvtpk(v[0], v[1]); w.y = cvtpk(v[2], v[3]); *(u32x2*)(xb + (size_t)m * D + 4 * lane + 256 * j) = w; }
        s = wave_sum(s);
        if (lane == 0) ss[m] = s;
    }
    const int gt = gw * 64 + lane, GT = NGW * 64;
    for (int i = gt; i < 7 * M; i += GT) ss[M + i] = 0.f;
}

template <int STAGE> DI void conv_stage(const Params& p, LAS unsigned char* lds, int rank, int nranks, int wave, int lane) {
    const int r8 = rank * 8 + wave, n8 = nranks * 8;
    if (STAGE == 1) conv_items(p, lds, CV_D0, CV_D0 + CV_D, CV_W0, CV_W0 + CV_IN, 0, 0, r8, n8, wave, lane);
    if (STAGE == 2) conv_items(p, lds, CV_W0 + CV_IN, CV_W0 + CV_IN + CV_O, 2 * CV_GU, 4 * CV_GU, CV_D0 + CV_D, CV_D0 + 2 * CV_D, r8, n8, wave, lane);
    if (STAGE == 3) conv_items(p, lds, 4 * CV_GU, 6 * CV_GU, CV_D0 + 2 * CV_D, CV_D0 + 3 * CV_D, 0, 0, r8, n8, wave, lane);
    if (STAGE == 4) conv_items(p, lds, CV_W0 + CV_IN + CV_O, CV_END, 6 * CV_GU, 8 * CV_GU, CV_D0 + 3 * CV_D, CV_D0 + 4 * CV_D, r8, n8, wave, lane);
}

template <class T> DI T ldg(const void* sbase, unsigned voff) { return *(const T*)((const char*)sbase + voff); }
template <class T> DI void stg(void* sbase, unsigned voff, T v) { *(T*)((char*)sbase + voff) = v; }

DI void dma16(const void* g, LAS unsigned char* l) { __builtin_amdgcn_global_load_lds((const unsigned*)g, (LAS unsigned*)l, 16, 0, 0); }
#define VM_WAIT0() asm volatile("s_waitcnt vmcnt(0)" ::: "memory")
#define LGKM_WAIT0() asm volatile("s_waitcnt lgkmcnt(0)" ::: "memory")

constexpr int HG_BUF = 11264;
DI void hgrn_item(const Ctx& C, LAS unsigned char* wl, int lane, size_t row0, int nblk, int h, int dvs, const float* s0, float* sout) {
    asm volatile("" : "+v"(lane));
    const int r = lane & 31, hh = lane >> 5, i16 = lane & 15, q = i16 >> 2, p = i16 & 3, g16 = (lane >> 4) & 1;
    const unsigned offF = (unsigned)lane * 16u;
    const unsigned offKH = (unsigned)((lane >> 4) * D) * 2u + (unsigned)(((lane & 15) ^ (((lane >> 4) & 3) << 2)) * 16);
    const unsigned offVA = (unsigned)((lane >> 2) * D) * 2u + (unsigned)((lane & 3) * 16);
    const unsigned offDC = (unsigned)((lane & 31) * 16);
    const unsigned offO = (unsigned)(4 * hh * 2048 + r) * 2u, offS = (unsigned)(4 * hh * 128 + r) * 4u;
    f32x16 S[4];
#pragma unroll
    for (int dkb = 0; dkb < 4; ++dkb)
#pragma unroll
        for (int i = 0; i < 16; ++i) S[dkb][i] = s0 ? ldg<float>(s0 + (size_t)(32 * dkb + (i & 3) + 8 * (i >> 2)) * 128 + 32 * dvs, offS) : 0.f;
    const unsigned vrd = (unsigned)((4 * hh + q) * 64 + 32 * g16 + 8 * p) + 8192u;
    unsigned krd[4];
#pragma unroll
    for (int dkb = 0; dkb < 4; ++dkb) krd[dkb] = (unsigned)((4 * hh + q) * 256 + (((dkb ^ q) * 4 + 2 * g16 + (p >> 1)) * 16) + (p & 1) * 8);
    const unsigned drd = 10240u + 16u * hh;
    u32x4 qn[8], kn[8];
#define HG_ISSUE(blk_, buf_) do { const size_t t1_ = row0 + 32 * (size_t)(blk_); LAS unsigned char* bb_ = wl + (buf_) * HG_BUF; \
        const bf16_t* KHb_ = C.KH + t1_ * D + h * 128; const bf16_t* VAb_ = C.VA + t1_ * D + h * 128 + dvs * 32; const float* DCb_ = C.DEC + (t1_ >> 5) * D + h * 128; \
        _Pragma("unroll") for (int j_ = 0; j_ < 8; ++j_) dma16((const char*)(KHb_ + (size_t)j_ * 4 * D) + offKH, bb_ + j_ * 1024); \
        _Pragma("unroll") for (int j_ = 0; j_ < 2; ++j_) dma16((const char*)(VAb_ + (size_t)j_ * 16 * D) + offVA, bb_ + 8192 + j_ * 1024); \
        dma16((const char*)DCb_ + offDC, bb_ + 10240); \
        const bf16_t* QTb_ = C.QT + ((t1_ >> 5) * 8 + h) * 4096; const bf16_t* KTb_ = C.KT + ((t1_ >> 5) * 8 + h) * 4096; \
        _Pragma("unroll") for (int kk_ = 0; kk_ < 8; ++kk_) { qn[kk_] = ldg<u32x4>(QTb_ + 512 * kk_, offF); kn[kk_] = ldg<u32x4>(KTb_ + 512 * kk_, offF); } } while (0)
    LGKM_WAIT0();
    HG_ISSUE(0, 0);
    for (int blk = 0; blk < nblk; ++blk) {
        const size_t t0 = row0 + 32 * (size_t)blk;
        const LAS unsigned char* bb = wl + (blk & 1) * HG_BUF;
        bf16_t* MXb = C.MIX + t0 * 2048 + h * 128 + dvs * 32;
        VM_WAIT0();
        bf16x8 qf[8];
        f32x16 sc;
#pragma unroll
        for (int i = 0; i < 16; ++i) sc[i] = 0.f;
#pragma unroll
        for (int kk = 0; kk < 8; ++kk) { qf[kk] = __builtin_bit_cast(bf16x8, qn[kk]); sc = MFMA32(__builtin_bit_cast(bf16x8, kn[kk]), qf[kk], sc); }
#pragma unroll
        for (int i = 0; i < 16; ++i) if (crow(i, hh) > r) sc[i] = 0.f;
        FENCE();
        if (blk + 1 < nblk) HG_ISSUE(blk + 1, (blk + 1) & 1);
        FENCE();
        bf16x8 vf[2];
#pragma unroll
        for (int ks = 0; ks < 2; ++ks) vf[ks] = cat8(vtr(bb + vrd + 16 * ks * 64), vtr(bb + vrd + (16 * ks + 8) * 64));
        f32x16 o;
#pragma unroll
        for (int i = 0; i < 16; ++i) o[i] = 0.f;
#pragma unroll
        for (int ks = 0; ks < 2; ++ks) o = MFMA32(pack8(sc, ks), vf[ks], o);
#pragma unroll
        for (int dkb = 0; dkb < 4; ++dkb)
#pragma unroll
            for (int ks = 0; ks < 2; ++ks) o = MFMA32(qf[2 * dkb + ks], pack8(S[dkb], ks), o);
#pragma unroll
        for (int i = 0; i < 16; ++i) stg<bf16_t>(MXb + (size_t)((i & 3) + 8 * (i >> 2)) * 2048, offO, f2bf(o[i]));
#pragma unroll
        for (int dkb = 0; dkb < 4; ++dkb) {
#pragma unroll
            for (int g4 = 0; g4 < 4; ++g4) { const f32x4 dv = *(const LAS f32x4*)(bb + drd + (32 * dkb + 8 * g4) * 4);
#pragma unroll
                for (int e = 0; e < 4; ++e) S[dkb][4 * g4 + e] *= dv[e]; }
#pragma unroll
            for (int ks = 0; ks < 2; ++ks) {
                const bf16x8 kh = cat8(vtr(bb + krd[dkb] + 16 * ks * 256), vtr(bb + krd[dkb] + (16 * ks + 8) * 256));
                S[dkb] = MFMA32(kh, vf[ks], S[dkb]);
            }
        }
    }
#undef HG_ISSUE
#pragma unroll
    for (int dkb = 0; dkb < 4; ++dkb)
#pragma unroll
        for (int i = 0; i < 16; ++i) stg<float>(sout + (size_t)(32 * dkb + (i & 3) + 8 * (i >> 2)) * 128 + 32 * dvs, offS, S[dkb][i]);
}

template <bool SAMPLE>
DI void attn_unit(const Ctx& C, LAS unsigned char* wl, int lane, int b, int h, int qb) {
    asm volatile("" : "+v"(lane));
    const int r = lane & 31, hh = lane >> 5, i16 = lane & 15, q = i16 >> 2, p = i16 & 3, g16 = (lane >> 4) & 1;
    const size_t qrow0 = SAMPLE ? (size_t)MP + b * 32 : (size_t)b * SEQ + qb * 32;
    const float* gq = C.in[17]; const float* gk = C.in[18];
    const unsigned offF = (unsigned)(r * D + 8 * hh) * 2u;
    const unsigned offL = (unsigned)lane * 16u;
    const unsigned offG = (unsigned)(8 * hh) * 4u;
    const unsigned swz = (unsigned)(((lane & 15) ^ (((lane >> 4) & 3) << 2)) * 16);
    const unsigned offVd = (unsigned)((lane >> 4) * D) * 2u + swz;
    const unsigned offV = (unsigned)((lane >> 4) * D + (lane & 15) * 8) * 2u;
    const unsigned offO = (unsigned)(4 * hh * 2048 + r) * 2u;
    LAS unsigned char* vwr = wl + (lane >> 4) * 256 + swz;
    unsigned vrd[4];
#pragma unroll
    for (int db = 0; db < 4; ++db) vrd[db] = (unsigned)((4 * hh + q) * 256 + (((db ^ q) * 4 + 2 * g16 + (p >> 1)) * 16) + (p & 1) * 8);
    LAS unsigned char* qimg = wl + 8192 + lane * 16;
    LGKM_WAIT0();
    {
        u32x4 raw[8]; float ss = 0.f;
        const bf16_t* src = C.QB + ((qrow0 >> 5) * 8 + h) * 4096;
#pragma unroll
        for (int s = 0; s < 8; ++s) { raw[s] = ldg<u32x4>(src + 512 * s, offL);
#pragma unroll
            for (int e = 0; e < 4; ++e) { const float a = bflo(raw[s][e]), c = bfhi(raw[s][e]); ss += a * a + c * c; } }
        ss += __shfl_xor(ss, 32);
        const float rs = rsqrtf(ss * (1.f / 128.f) + EPS) * 0.08838834764831845f;
#pragma unroll
        for (int s = 0; s < 8; ++s) { f32x4 g0 = ldg<f32x4>(gq + 16 * s, offG), g1 = ldg<f32x4>(gq + 16 * s + 4, offG);
            if (!SAMPLE) { g0 *= ldg<f32x4>(gk + 16 * s, offG); g1 *= ldg<f32x4>(gk + 16 * s + 4, offG); }
            u32x4 w; w.x = cvtpk(bflo(raw[s].x) * rs * g0[0], bfhi(raw[s].x) * rs * g0[1]); w.y = cvtpk(bflo(raw[s].y) * rs * g0[2], bfhi(raw[s].y) * rs * g0[3]);
            w.z = cvtpk(bflo(raw[s].z) * rs * g1[0], bfhi(raw[s].z) * rs * g1[1]); w.w = cvtpk(bflo(raw[s].w) * rs * g1[2], bfhi(raw[s].w) * rs * g1[3]);
            *(LAS u32x4*)(qimg + s * 1024) = w; }
    }
    f32x16 O[4];
#pragma unroll
    for (int db = 0; db < 4; ++db)
#pragma unroll
        for (int i = 0; i < 16; ++i) O[db][i] = 0.f;
    float R = 0.f;
    const int ntiles = SAMPLE ? 65 : qb + 1;
    u32x4 kr[8];
    if (!SAMPLE) {
        const bf16_t* src = C.KB + ((qrow0 >> 5) * 8 + h) * 4096; const bf16_t* vsrc = C.VB + qrow0 * D + h * 128;
#pragma unroll
        for (int s = 0; s < 8; ++s) kr[s] = ldg<u32x4>(src + 512 * s, offL);
#pragma unroll
        for (int j = 0; j < 8; ++j) dma16((const char*)(vsrc + (size_t)j * 4 * D) + offVd, wl + j * 1024);
    }
    for (int it = 0; it < ntiles; ++it) {
        const bool diag = it == 0;
        const bool cache = SAMPLE && !diag;
        f32x16 z;
#pragma unroll
        for (int i = 0; i < 16; ++i) z[i] = 0.f;
        if (!cache) {
            const size_t krow0 = SAMPLE ? (size_t)MP + b * 32 : (size_t)b * SEQ + (qb - it) * 32;
            float ss = 0.f;
            if (SAMPLE) { const bf16_t* src = C.KB + ((krow0 >> 5) * 8 + h) * 4096;
#pragma unroll
                for (int s = 0; s < 8; ++s) kr[s] = ldg<u32x4>(src + 512 * s, offL); }
#pragma unroll
            for (int s = 0; s < 8; ++s)
#pragma unroll
                for (int e = 0; e < 4; ++e) { const float a = bflo(kr[s][e]), c = bfhi(kr[s][e]); ss += a * a + c * c; }
            ss += __shfl_xor(ss, 32);
            const float rs = rsqrtf(ss * (1.f / 128.f) + EPS);
            if (diag) {
                float* ko = (SAMPLE ? C.out + OUT_KS + (size_t)b * 32 * D : C.out + OUT_KP + krow0 * D) + h * 128;
#pragma unroll
                for (int s = 0; s < 8; ++s) { const f32x4 g0 = ldg<f32x4>(gk + 16 * s, offG), g1 = ldg<f32x4>(gk + 16 * s + 4, offG);
                    const f32x4 k0 = {bflo(kr[s].x) * rs * g0[0], bfhi(kr[s].x) * rs * g0[1], bflo(kr[s].y) * rs * g0[2], bfhi(kr[s].y) * rs * g0[3]};
                    const f32x4 k1 = {bflo(kr[s].z) * rs * g1[0], bfhi(kr[s].z) * rs * g1[1], bflo(kr[s].w) * rs * g1[2], bfhi(kr[s].w) * rs * g1[3]};
                    stg<f32x4>(ko + 16 * s, offF * 2u, k0); stg<f32x4>(ko + 16 * s + 4, offF * 2u, k1);
                    if (SAMPLE) z = MFMA32(pack8f(k0, k1), *(const LAS bf16x8*)(qimg + s * 1024), z);
                    if ((s & 3) == 3) FENCE(); }
            }
            if (!SAMPLE) {
#pragma unroll
                for (int s = 0; s < 8; ++s) z = MFMA32(__builtin_bit_cast(bf16x8, kr[s]), *(const LAS bf16x8*)(qimg + s * 1024), z);
#pragma unroll
                for (int i = 0; i < 16; ++i) { const float ra = __builtin_bit_cast(float, __builtin_amdgcn_readlane(__builtin_bit_cast(int, rs), (i & 3) + 8 * (i >> 2))),
                                                           rb = __builtin_bit_cast(float, __builtin_amdgcn_readlane(__builtin_bit_cast(int, rs), (i & 3) + 8 * (i >> 2) + 4));
                    z[i] *= hh ? rb : ra; }
                FENCE();
                if (it + 1 < ntiles) {
                    const bf16_t* src = C.KB + (((krow0 - 32) >> 5) * 8 + h) * 4096;
#pragma unroll
                    for (int s = 0; s < 8; ++s) kr[s] = ldg<u32x4>(src + 512 * s, offL);
                }
                FENCE();
            } else {
                FENCE();
                const bf16_t* vsrc = C.VB + krow0 * D + h * 128;
#pragma unroll
                for (int i8 = 0; i8 < 8; ++i8) { *(LAS u32x4*)(vwr + i8 * 1024) = ldg<u32x4>(vsrc + (size_t)i8 * 4 * D, offV); if ((i8 & 3) == 3) FENCE(); }
            }
        } else {
            const int kt = 64 - it;
            const float* src = C.in[2] + ((size_t)b * 2048 + kt * 32) * D + h * 128;
#pragma unroll
            for (int s = 0; s < 8; ++s) { const f32x4 k0 = ldg<f32x4>(src + 16 * s, offF * 2u), k1 = ldg<f32x4>(src + 16 * s + 4, offF * 2u); z = MFMA32(pack8f(k0, k1), *(const LAS bf16x8*)(qimg + s * 1024), z); if ((s & 3) == 3) FENCE(); }
            const float* vsrc = C.in[3] + ((size_t)b * 2048 + kt * 32) * D + h * 128;
#pragma unroll
            for (int i8 = 0; i8 < 8; ++i8) { const f32x4 v0 = ldg<f32x4>(vsrc + (size_t)i8 * 4 * D, offV * 2u), v1 = ldg<f32x4>(vsrc + (size_t)i8 * 4 * D + 4, offV * 2u);
                *(LAS bf16x8*)(vwr + i8 * 1024) = pack8f(v0, v1); if (i8 & 1) FENCE(); }
        }
        FENCE();
        float ls[16];
#pragma unroll
        for (int i = 0; i < 16; ++i) { const float zz = z[i]; ls[i] = -(fmaxf(zz, 0.f) + __logf(1.f + __expf(-fabsf(zz)))); }
        if (diag) {
#pragma unroll
            for (int i = 0; i < 16; ++i) if (crow(i, hh) >= r) { ls[i] = 0.f; z[i] = -INFINITY; }
        }
        float gs[4], og[4];
#pragma unroll
        for (int g = 0; g < 4; ++g) { gs[g] = (ls[4 * g] + ls[4 * g + 1]) + (ls[4 * g + 2] + ls[4 * g + 3]); og[g] = __shfl_xor(gs[g], 32); }
        float tail = R;
#pragma unroll
        for (int g = 3; g >= 0; --g) {
            float run = tail + (hh == 0 ? og[g] : 0.f);
#pragma unroll
            for (int e = 3; e >= 0; --e) { const float l = ls[4 * g + e]; z[4 * g + e] = __expf(z[4 * g + e] + l + run); run += l; }
            tail += gs[g] + og[g];
        }
        R = tail;
        FENCE();
        if (!SAMPLE) VM_WAIT0();
#pragma unroll
        for (int ks = 0; ks < 2; ++ks) {
            const bf16x8 pa = pack8(z, ks);
#pragma unroll
            for (int db = 0; db < 4; ++db) {
                const bf16x8 vf = cat8(vtr(wl + vrd[db] + 16 * ks * 256), vtr(wl + vrd[db] + (16 * ks + 8) * 256));
                O[db] = MFMA32(pa, vf, O[db]);
            }
        }
        if (__all(R < -30.f)) break;
        if (!SAMPLE && it + 1 < ntiles) {
            LGKM_WAIT0();
            const bf16_t* vsrc = C.VB + ((size_t)b * SEQ + (qb - it - 1) * 32) * D + h * 128;
#pragma unroll
            for (int j = 0; j < 8; ++j) dma16((const char*)(vsrc + (size_t)j * 4 * D) + offVd, wl + j * 1024);
        }
    }
    bf16_t* mo = C.MIX + qrow0 * 2048 + 1024 + h * 128;
#pragma unroll
    for (int db = 0; db < 4; ++db)
#pragma unroll
        for (int i = 0; i < 16; ++i) stg<bf16_t>(mo + (size_t)((i & 3) + 8 * (i >> 2)) * 2048 + 32 * db, offO, f2bf(O[db][i]));
}

DI void spatial_unit(const Params& P, LAS unsigned char* wl, int lane, int unit) {
    asm volatile("" : "+v"(lane));
    const int r = lane & 31, hh = lane >> 5, i16 = lane & 15, q = i16 >> 2, p = i16 & 3, g16 = (lane >> 4) & 1;
    const bool sample = unit >= 8192;
    const int uu = sample ? unit - 8192 : unit;
    const int cs = uu & 3, g = (uu >> 2) & 7, chunk = uu >> 5;
    const size_t rbase = sample ? (size_t)MP + chunk * 32 : (size_t)chunk * 128;
    const int L = sample ? 32 : 128;
    const int c0 = g * 256 + cs * 64;
    const bf16_t* U = (const bf16_t*)(P.ws + WS_U) + rbase * 2048 + c0; const bf16_t* V = (const bf16_t*)(P.ws + WS_V) + rbase * 2048 + c0; bf16_t* GT = (bf16_t*)(P.ws + WS_GATED) + rbase * 2048 + c0;
    const float* vst = (const float*)(P.ws + WS_VST) + 2 * rbase;
    const float* lng = P.in[21] + c0; const float* lnb = P.in[22] + c0; const float* wsp = P.in[23] + (size_t)g * 128 * 128; const float* bsp = P.in[24] + g * 128;
    {
        const int ch = lane & 7;
        const unsigned offC = (unsigned)(ch * 8) * 4u;
        const f32x4 ga = ldg<f32x4>(lng, offC), gb = ldg<f32x4>(lng + 4, offC), ba = ldg<f32x4>(lnb, offC), bb = ldg<f32x4>(lnb + 4, offC);
        const unsigned offR = (unsigned)((lane >> 3) * 2048 + ch * 8) * 2u, offS = (unsigned)(lane >> 3) * 8u;
        LAS unsigned char* wr_ = wl + (ch >> 2) * 8192 + (lane >> 3) * 64 + (ch & 3) * 16;
        float* gvo = P.out + OUT_GV + (size_t)chunk * 32 * 2048 + c0;
#pragma unroll 4
        for (int it = 0; it < L / 8; ++it) {
            const u32x4 raw = ldg<u32x4>(V + (size_t)it * 8 * 2048, offR);
            const f32x2_t st = ldg<f32x2_t>(vst + it * 16, offS);
            const float mean = st.x * (1.f / 2048.f), var = st.y * (1.f / 2048.f) - mean * mean, rs = rsqrtf(fmaxf(var, 0.f) + EPS);
            f32x4 x0 = {bflo(raw.x), bfhi(raw.x), bflo(raw.y), bfhi(raw.y)}, x1 = {bflo(raw.z), bfhi(raw.z), bflo(raw.w), bfhi(raw.w)};
            x0 = (x0 - mean) * rs * ga + ba; x1 = (x1 - mean) * rs * gb + bb;
            if (sample) { stg<f32x4>(gvo + (size_t)it * 8 * 2048, offR * 2u, x0); stg<f32x4>(gvo + (size_t)it * 8 * 2048 + 4, offR * 2u, x1); }
            *(LAS bf16x8*)(wr_ + it * 8 * 64) = pack8f(x0, x1);
        }
    }
    const LAS unsigned char* brd = wl + (8 * hh + q) * 64 + 32 * g16 + 8 * p;
    bf16x8 bfr[2][8];
#pragma unroll
    for (int db = 0; db < 2; ++db)
#pragma unroll
        for (int kk = 0; kk < 8; ++kk)
            if (kk * 16 < L) bfr[db][kk] = cat8(vtr(brd + db * 8192 + 16 * kk * 64), vtr(brd + db * 8192 + (16 * kk + 4) * 64));
            else bfr[db][kk] = (bf16x8){0, 0, 0, 0, 0, 0, 0, 0};
    const int ntile = L / 32;
    const unsigned offW = (unsigned)(r * 128 + 8 * hh) * 4u, offU = (unsigned)(4 * hh * 2048 + r) * 2u, offB = (unsigned)(4 * hh) * 4u;
    for (int itile = 0; itile < ntile; ++itile) {
        const int nk = sample ? 2 : (itile < 2 ? 4 : 8);
        f32x16 a0, a1;
#pragma unroll
        for (int i = 0; i < 16; ++i) { a0[i] = 0.f; a1[i] = 0.f; }
        const float* wrow = wsp + (size_t)(32 * itile) * 128;
        const bf16_t* Ut = U + (size_t)(32 * itile) * 2048; bf16_t* Gt = GT + (size_t)(32 * itile) * 2048; const float* bt = bsp + 32 * itile;
        bf16_t uv0[16], uv1[16]; float bsv[16];
#pragma unroll
        for (int i = 0; i < 16; ++i) { const int io = (i & 3) + 8 * (i >> 2);
            bsv[i] = ldg<float>(bt + io, offB); uv0[i] = ldg<bf16_t>(Ut + (size_t)io * 2048, offU); uv1[i] = ldg<bf16_t>(Ut + (size_t)io * 2048 + 32, offU); }
#pragma unroll
        for (int kk = 0; kk < 8; ++kk) if (kk < nk) {
            const f32x4 w0 = ldg<f32x4>(wrow + 16 * kk, offW), w1 = ldg<f32x4>(wrow + 16 * kk + 4, offW);
            const bf16x8 af = pack8f(w0, w1);
            a0 = MFMA32(af, bfr[0][kk], a0); a1 = MFMA32(af, bfr[1][kk], a1);
        }
#pragma unroll
        for (int i = 0; i < 16; ++i) {
            const int io = (i & 3) + 8 * (i >> 2);
            stg<bf16_t>(Gt + (size_t)io * 2048, offU, f2bf(bf2f(uv0[i]) * (a0[i] + bsv[i]))); stg<bf16_t>(Gt + (size_t)io * 2048 + 32, offU, f2bf(bf2f(uv1[i]) * (a1[i] + bsv[i])));
        }
    }
}


template <bool NEXT>
DI void small_gemm_res(LAS unsigned char* lds, const bf16_t* A  , const bf16_t* Bt  , int K, const float* res  ,
                       float* out, bf16_t* xb, float* ss_out, float scale, int unit0, int G) {
    int tid = threadIdx.x; asm volatile("" : "+v"(tid));
    const int lane = tid & 63, wave = __builtin_amdgcn_readfirstlane(tid >> 6), r = lane & 31, hh = lane >> 5;
    const int Kw = K >> 3;
    const unsigned offA = (unsigned)(r * K + 8 * hh) * 2u;
    for (int unit = unit0; unit < 256; unit += G) {
        const int tm = unit >> 4, tn = unit & 15;
        const bf16_t* A0 = A + (size_t)(tm * 64) * K + wave * Kw; const bf16_t* A1 = A0 + (size_t)32 * K;
        const bf16_t* B0 = Bt + (size_t)(tn * 64) * K + wave * Kw; const bf16_t* B1 = B0 + (size_t)32 * K;
        f32x16 c00, c01, c10, c11;
#pragma unroll
        for (int i = 0; i < 16; ++i) { c00[i] = 0.f; c01[i] = 0.f; c10[i] = 0.f; c11[i] = 0.f; }
        u32x4 a0[2], a1[2], b0[2], b1[2], an0[2], an1[2], bn0[2], bn1[2];
#pragma unroll
        for (int j = 0; j < 2; ++j) { a0[j] = ldg<u32x4>(A0 + 16 * j, offA); a1[j] = ldg<u32x4>(A1 + 16 * j, offA); b0[j] = ldg<u32x4>(B0 + 16 * j, offA); b1[j] = ldg<u32x4>(B1 + 16 * j, offA); }
        for (int k = 0; k < Kw; k += 32) {
            const int kn = (k + 32 < Kw) ? k + 32 : k;
#pragma unroll
            for (int j = 0; j < 2; ++j) { an0[j] = ldg<u32x4>(A0 + kn + 16 * j, offA); an1[j] = ldg<u32x4>(A1 + kn + 16 * j, offA); bn0[j] = ldg<u32x4>(B0 + kn + 16 * j, offA); bn1[j] = ldg<u32x4>(B1 + kn + 16 * j, offA); }
            FENCE();
#pragma unroll
            for (int j = 0; j < 2; ++j) {
                const bf16x8 fa0 = __builtin_bit_cast(bf16x8, a0[j]), fa1 = __builtin_bit_cast(bf16x8, a1[j]), fb0 = __builtin_bit_cast(bf16x8, b0[j]), fb1 = __builtin_bit_cast(bf16x8, b1[j]);
                c00 = MFMA32(fa0, fb0, c00); c01 = MFMA32(fa0, fb1, c01); c10 = MFMA32(fa1, fb0, c10); c11 = MFMA32(fa1, fb1, c11);
            }
#pragma unroll
            for (int j = 0; j < 2; ++j) { a0[j] = an0[j]; a1[j] = an1[j]; b0[j] = bn0[j]; b1[j] = bn1[j]; }
        }
        __syncthreads();
        LAS float* pl = (LAS float*)(lds + wave * 16384);
#pragma unroll
        for (int i = 0; i < 16; ++i) { const int row = crow(i, hh); pl[row * 64 + r] = c00[i]; pl[row * 64 + 32 + r] = c01[i]; pl[(32 + row) * 64 + r] = c10[i]; pl[(32 + row) * 64 + 32 + r] = c11[i]; }
        __syncthreads();
        const int row = tid >> 3, cb = (tid & 7) * 8;
        f32x4 s0 = *(const LAS f32x4*)(lds + (row * 64 + cb) * 4), s1 = *(const LAS f32x4*)(lds + (row * 64 + cb + 4) * 4);
#pragma unroll
        for (int pq = 1; pq < 8; ++pq) { s0 += *(const LAS f32x4*)(lds + pq * 16384 + (row * 64 + cb) * 4); s1 += *(const LAS f32x4*)(lds + pq * 16384 + (row * 64 + cb + 4) * 4); }
        const size_t off = (size_t)(tm * 64 + row) * D + tn * 64 + cb;
        const f32x4 x0 = *(const f32x4*)(res + off) + s0 * scale, x1 = *(const f32x4*)(res + off + 4) + s1 * scale;
        *(f32x4*)(out + off) = x0; *(f32x4*)(out + off + 4) = x1;
        if (NEXT) {
            u32x4 w; w.x = cvtpk(x0[0], x0[1]); w.y = cvtpk(x0[2], x0[3]); w.z = cvtpk(x1[0], x1[1]); w.w = cvtpk(x1[2], x1[3]);
            *(u32x4*)(xb + off) = w;
            float sq = (x0[0] * x0[0] + x0[1] * x0[1]) + (x0[2] * x0[2] + x0[3] * x0[3]) + (x1[0] * x1[0] + x1[1] * x1[1]) + (x1[2] * x1[2] + x1[3] * x1[3]);
            sq += __shfl_xor(sq, 1); sq += __shfl_xor(sq, 2); sq += __shfl_xor(sq, 4);
            if ((tid & 7) == 0) atomicAdd(ss_out + tm * 64 + row, sq);
        }
    }
    __syncthreads();
}

#define XB_TMO      128
#define XB_XCNT(j)  (256  + 64 * (j))
#define XB_XSUB(j)  (1280 + 64 * (j))
#define XB_XGEN(j)  (2304 + 64 * (j))
#define XB_TOP      3328
#define XB_TOPGEN   3392
#define XCD_BAR_WORDS 3456
#define XB_SPIN_CAP (1u << 22)
DI unsigned xb_ld(unsigned* p)              { return __hip_atomic_load(p, __ATOMIC_RELAXED, __HIP_MEMORY_SCOPE_AGENT); }
DI unsigned xb_add(unsigned* p, unsigned v) { return __hip_atomic_fetch_add(p, v, __ATOMIC_RELAXED, __HIP_MEMORY_SCOPE_AGENT); }
DI unsigned xb_xcc_id() { return (unsigned)__builtin_amdgcn_s_getreg((3 << 11) | 20) & 0xFu; }
#define XB_SPIN(cond, bar) do { unsigned _sp = 0; while (cond) { __builtin_amdgcn_s_sleep(1); \
    if ((++_sp & 255u) == 0u) { if (xb_ld(&(bar)[XB_TMO])) break; if (_sp > XB_SPIN_CAP) { atomicAdd(&(bar)[XB_TMO], 1u); break; } } } } while (0)
struct XcdBarrier { unsigned* bar; unsigned x; volatile LAS unsigned* st; };
DI XcdBarrier xcd_barrier_post(unsigned* bar, volatile LAS unsigned* st) {
    XcdBarrier b; b.bar = bar; b.x = xb_xcc_id(); b.st = st;
    if (threadIdx.x == 0) (void)xb_add(&bar[XB_XCNT(b.x)], 1u);
    return b;
}
DI void xcd_barrier_complete(unsigned* bar, unsigned x, unsigned& nloc, unsigned& nx) {
    const unsigned G = gridDim.x * gridDim.y * gridDim.z;
    unsigned sum, cnt, mine, sp = 0u;
    for (;;) {
        sum = 0u; cnt = 0u; mine = 0u;
#pragma unroll
        for (unsigned j = 0; j < 16; ++j) { const unsigned c = xb_ld(&bar[XB_XCNT(j)]); sum += c; cnt += (c > 0u) ? 1u : 0u; mine = (j == x) ? c : mine; }
        if (sum == G) break;
        __builtin_amdgcn_s_sleep(1);
        if ((++sp & 255u) == 0u) { if (xb_ld(&bar[XB_TMO])) break; if (sp > XB_SPIN_CAP) { atomicAdd(&bar[XB_TMO], 1u); break; } }
    }
    nloc = mine > 0u ? mine : 1u; nx = cnt > 0u ? cnt : 1u;
}
DI void xcd_barrier(const XcdBarrier& b) {
    asm volatile("s_waitcnt vmcnt(0)" ::: "memory");
    __syncthreads();
    if (threadIdx.x == 0) {
        unsigned* bar = b.bar;
        __builtin_amdgcn_s_waitcnt(0);
        unsigned nloc = b.st[0], nx = b.st[1];
        if (nloc == 0u) { xcd_barrier_complete(bar, b.x, nloc, nx); b.st[0] = nloc; b.st[1] = nx; }
        const unsigned old = xb_add(&bar[XB_XSUB(b.x)], 1u);
        const unsigned gen = old / nloc;
        if (old + 1u == (gen + 1u) * nloc) {
            __builtin_amdgcn_fence(__ATOMIC_RELEASE, "agent");
            asm volatile("s_waitcnt vmcnt(0)" ::: "memory");
            const unsigned og = xb_add(&bar[XB_TOP], 1u);
            const unsigned tg = og / nx;
            if (og + 1u == (tg + 1u) * nx) xb_add(&bar[XB_TOPGEN], 1u);
            else XB_SPIN(xb_ld(&bar[XB_TOPGEN]) == tg, bar);
            __builtin_amdgcn_fence(__ATOMIC_ACQUIRE, "agent");
            xb_add(&bar[XB_XGEN(b.x)], 1u);
            asm volatile("s_waitcnt vmcnt(0)" ::: "memory");
        } else {
            XB_SPIN(xb_ld(&bar[XB_XGEN(b.x)]) == gen, bar);
            __builtin_amdgcn_fence(__ATOMIC_ACQUIRE, "agent");
            asm volatile("s_waitcnt vmcnt(0)" ::: "memory");
        }
    }
    __syncthreads();
}

__global__ void __launch_bounds__(512, 2) mega(Params p) {
    extern __shared__ __attribute__((aligned(16))) unsigned char lds_raw[];
    LAS unsigned char* lds = (LAS unsigned char*)lds_raw;
    cg::grid_group grid = cg::this_grid();
    const int tid = threadIdx.x, lane = tid & 63, wave = __builtin_amdgcn_readfirstlane(tid >> 6);
    const int G = gridDim.x, bx = blockIdx.x, gw = bx * 8 + wave, NGW = G * 8;
    unsigned char* ws = p.ws;
    float* ss = (float*)(ws + WS_SS);
    bf16_t* xb = (bf16_t*)(ws + WS_XB);
    bf16_t* gu = (bf16_t*)(ws + WS_GU);
    float* X = p.out + OUT_Y;
    Ctx C; C.in = p.in; C.out = p.out; C.ws = ws;
    C.QT = (bf16_t*)(ws + WS_QT); C.KT = (bf16_t*)(ws + WS_KT); C.KH = (bf16_t*)(ws + WS_KH); C.DEC = (float*)(ws + WS_DEC);
    C.VA = (bf16_t*)(ws + WS_VA); C.GA = (bf16_t*)(ws + WS_GA); C.QB = (bf16_t*)(ws + WS_QB); C.KB = (bf16_t*)(ws + WS_KB); C.VB = (bf16_t*)(ws + WS_VB); C.MIX = (bf16_t*)(ws + WS_MIX);

    volatile LAS unsigned* misc = (volatile LAS unsigned*)(lds + LDS_BYTES - 64);
    if (tid < 2) misc[tid] = 0u;
    if (bx == 0) for (int i = tid; i < XCD_BAR_WORDS; i += 512) ((unsigned*)(ws + WS_BAR))[i] = 0u;
    prologue(p, lds, gw, NGW, wave, lane);
    grid.sync();
    const XcdBarrier xbar = xcd_barrier_post((unsigned*)(ws + WS_BAR), misc);
#define GSYNC() xcd_barrier(xbar)

#define FFN(f, ssin, ssout, resp, ress, NEXTV, CST) do { \
        { pg8::Gemm g{xb, (const bf16_t*)(ws + WS_WGU) + (size_t)(f) * 5632 * 1024, M, 5632, D}; pg8::StaticOrder S; S.init(M, 5632, G, bx); \
          EpiGU E{gu, ss + (size_t)(ssin) * M}; pg8::gemm_phase<EpiGU, pg8::StaticOrder, true, true>(lds, g, S, E); \
          if (CST != 0) { const int rem_ = (132 * 22) % G; if (rem_ != 0 ? bx >= rem_ : true) conv_stage<CST>(p, lds, rem_ != 0 ? bx - rem_ : bx, rem_ != 0 ? G - rem_ : G, wave, lane); } } \
        GSYNC(); \
        { pg8::Gemm g{gu, (const bf16_t*)(ws + WS_WD) + (size_t)(f) * 1024 * DFF, MP, D, DFF}; pg8::StaticOrder S; S.init(MP, D, G, bx); \
          EpiRes<NEXTV> E{resp, ress, X, xb, ss + (size_t)(ssout) * M, 0.5f}; pg8::gemm_phase<EpiRes<NEXTV>, pg8::StaticOrder, true, true>(lds, g, S, E); \
          small_gemm_res<NEXTV>(lds, gu + (size_t)MP * DFF, (const bf16_t*)(ws + WS_WD) + (size_t)(f) * 1024 * DFF, DFF, ress, X + (size_t)MP * D, xb + (size_t)MP * D, ss + (size_t)(ssout) * M + MP, 0.5f, bx, G); } \
        if (NEXTV) GSYNC(); } while (0)

    FFN(0, 0, 1, p.in[0], p.in[1], true, 1);
    {
        pg8::Gemm g{xb, (const bf16_t*)(ws + WS_WIN), M, 7168, D}; pg8::StaticOrder S; S.init(M, 7168, G, bx);
        EpiIn E{ss + (size_t)1 * M, p.in[15], C.QT, C.KT, C.KH, C.DEC, C.VA, p.out + OUT_VP, p.out + OUT_VS};
        pg8::gemm_phase<EpiIn, pg8::StaticOrder, true, true>(lds, g, S, E);
        { const int rem_ = (132 * 28) % G; if (rem_ != 0 ? bx >= rem_ : true) conv_stage<2>(p, lds, rem_ != 0 ? bx - rem_ : bx, rem_ != 0 ? G - rem_ : G, wave, lane); }
    }
    GSYNC();
    {
        LAS unsigned char* wl = wave < 2 ? lds + wave * (2 * HG_BUF) : lds + 2 * (2 * HG_BUF) + (wave - 2) * 16384;
        if (wave < 2) {
            const int id = bx * 2 + wave;
            __builtin_amdgcn_s_setprio(3);
            if (G == 256) {
                const int bh = (bx & 7) + 8 * (bx >> 4), dvs = 2 * ((bx >> 3) & 1) + wave, b = bh >> 3, h = bh & 7;
                hgrn_item(C, wl, lane, (size_t)b * SEQ, SEQ / 32, h, dvs, nullptr, p.out + OUT_HP + (size_t)bh * 16384);
            } else if (id < 512) { const int bh = id >> 2, dvs = id & 3, b = bh >> 3, h = bh & 7;
                hgrn_item(C, wl, lane, (size_t)b * SEQ, SEQ / 32, h, dvs, nullptr, p.out + OUT_HP + (size_t)bh * 16384); }
            __builtin_amdgcn_s_setprio(0);
        } else {
            if (G == 256) {
                const int x = bx & 7, lw = (bx >> 3) * 6 + (wave - 2);
                for (int j = lw; j < 1024 + 32; j += 192) {
                    if (j < 1024) { const int bh = x + 8 * (j & 15), qb = 63 - (j >> 4); attn_unit<false>(C, wl, lane, bh >> 3, bh & 7, qb); }
                    else { const int v = (j - 1024) * 8 + x; attn_unit<true>(C, wl, lane, v >> 3, v & 7, 0); }
                }
            } else {
            const int aw = bx * 6 + (wave - 2), NAW = G * 6;
            for (int u = aw; u < 8192 + 512; u += NAW) {
                if (u < 8192) { const int bh = u & 127, qb = 63 - (u >> 7); attn_unit<false>(C, wl, lane, bh >> 3, bh & 7, qb); }
                else if (u >= 8192 + 256) { const int v = u - 8192 - 256; attn_unit<true>(C, wl, lane, v >> 3, v & 7, 0); }
            }
            }
            for (int sid = bx * 6 + (wave - 2); sid < 1024; sid += G * 6) {
                const int bh = sid >> 2, dvs = sid & 3, b = bh >> 3, h = bh & 7;
                hgrn_item(C, wl, lane, (size_t)MP + b * 32, 1, h, dvs, p.in[4] + (size_t)bh * 16384, p.out + OUT_HS + (size_t)bh * 16384); }
        }
    }
    GSYNC();
    {
        const float* gout = p.in[16];
#pragma unroll 2
        for (int m = gw; m < M; m += NGW) {
            bf16_t* mp = C.MIX + (size_t)m * 2048 + 16 * lane; const bf16_t* gp = C.GA + (size_t)m * D + 16 * lane;
            const u32x4 o0 = *(const u32x4*)mp, o1 = *(const u32x4*)(mp + 8), g0 = *(const u32x4*)gp, g1 = *(const u32x4*)(gp + 8);
            float ov[16], gv[16];
#pragma unroll
            for (int e = 0; e < 4; ++e) { ov[2 * e] = bflo(o0[e]); ov[2 * e + 1] = bfhi(o0[e]); ov[8 + 2 * e] = bflo(o1[e]); ov[8 + 2 * e + 1] = bfhi(o1[e]);
                                          gv[2 * e] = bflo(g0[e]); gv[2 * e + 1] = bfhi(g0[e]); gv[8 + 2 * e] = bflo(g1[e]); gv[8 + 2 * e + 1] = bfhi(g1[e]); }
            float sq = 0.f;
#pragma unroll
            for (int e = 0; e < 16; ++e) sq += ov[e] * ov[e];
            sq += __shfl_xor(sq, 1); sq += __shfl_xor(sq, 2); sq += __shfl_xor(sq, 4);
            const float rs = rsqrtf(sq * (1.f / 128.f) + EPS);
            float res[16];
#pragma unroll
            for (int e = 0; e < 16; ++e) res[e] = ov[e] * rs * gout[16 * lane + e] * fsigmoid(gv[e]);
            u32x4 w0, w1;
            w0.x = cvtpk(res[0], res[1]); w0.y = cvtpk(res[2], res[3]); w0.z = cvtpk(res[4], res[5]); w0.w = cvtpk(res[6], res[7]);
            w1.x = cvtpk(res[8], res[9]); w1.y = cvtpk(res[10], res[11]); w1.z = cvtpk(res[12], res[13]); w1.w = cvtpk(res[14], res[15]);
            *(u32x4*)mp = w0; *(u32x4*)(mp + 8) = w1;
        }
    }
    GSYNC();
    {
        pg8::Gemm g{C.MIX, (const bf16_t*)(ws + WS_WOUT), MP, D, 2048}; pg8::StaticOrder S; S.init(MP, D, G, bx);
        EpiRes<true> E{X, X + (size_t)MP * D, X, xb, ss + (size_t)2 * M, 1.0f};
        pg8::gemm_phase<EpiRes<true>, pg8::StaticOrder, true, true>(lds, g, S, E);
        small_gemm_res<true>(lds, C.MIX + (size_t)MP * 2048, (const bf16_t*)(ws + WS_WOUT), 2048, X + (size_t)MP * D, X + (size_t)MP * D, xb + (size_t)MP * D, ss + (size_t)2 * M + MP, 1.0f, bx, G);
    }
    GSYNC();
    FFN(1, 2, 3, X, X + (size_t)MP * D, true, 3);
    FFN(2, 3, 4, X, X + (size_t)MP * D, true, 4);
    {
        pg8::Gemm g{xb, (const bf16_t*)(ws + WS_WCIN), M, 4096, D}; pg8::StaticOrder S; S.init(M, 4096, G, bx);
        EpiCin E{ss + (size_t)4 * M, (bf16_t*)(ws + WS_U), (bf16_t*)(ws + WS_V), (float*)(ws + WS_VST)};
        pg8::gemm_phase<EpiCin, pg8::StaticOrder, true, true>(lds, g, S, E);
    }
    GSYNC();
    {
        LAS unsigned char* wl = lds + wave * 16384;
        for (int u = gw; u < 8192 + 1024; u += NGW) spatial_unit(p, wl, lane, u);
    }
    GSYNC();
    {
        pg8::Gemm g{(const bf16_t*)(ws + WS_GATED), (const bf16_t*)(ws + WS_WCOUT), MP, D, 2048}; pg8::StaticOrder S; S.init(MP, D, G, bx);
        EpiRes<true> E{X, X + (size_t)MP * D, X, xb, ss + (size_t)5 * M, 1.0f};
        pg8::gemm_phase<EpiRes<true>, pg8::StaticOrder, true, true>(lds, g, S, E);
        small_gemm_res<true>(lds, (const bf16_t*)(ws + WS_GATED) + (size_t)MP * 2048, (const bf16_t*)(ws + WS_WCOUT), 2048, X + (size_t)MP * D, X + (size_t)MP * D, xb + (size_t)MP * D, ss + (size_t)5 * M + MP, 1.0f, bx, G);
    }
    GSYNC();
    FFN(3, 5, 5, X, X + (size_t)MP * D, false, 0);
}

extern "C" void kernel_launch(void* const* d_in, const int* in_sizes, int n_in, void* d_out, int out_size, void* d_ws, size_t ws_size, hipStream_t stream) {
    static int grid = 0;
    if (grid == 0) {
        int dev = 0, cus = 0, per_cu = 0;
        (void)hipGetDevice(&dev);
        (void)hipDeviceGetAttribute(&cus, hipDeviceAttributeMultiprocessorCount, dev);
        (void)hipFuncSetAttribute((const void*)mega, hipFuncAttributeMaxDynamicSharedMemorySize, LDS_BYTES);
        (void)hipOccupancyMaxActiveBlocksPerMultiprocessor(&per_cu, (const void*)mega, 512, LDS_BYTES);
        if (per_cu < 1) per_cu = 1;
        grid = cus * per_cu;
        if (n_in != 26 || (size_t)out_size != OUT_TOTAL || ws_size < WS_END) { fprintf(stderr, "kernel_launch: unexpected sizes n_in %d out %d ws %zu\n", n_in, out_size, ws_size); grid = -1; }
    }
    if (grid < 0) return;
    Params p{};
    for (int i = 0; i < 26; ++i) p.in[i] = (const float*)d_in[i];
    p.out = (float*)d_out; p.ws = (unsigned char*)d_ws;
    void* args[] = {&p};
    hipError_t e = hipLaunchCooperativeKernel((const void*)mega, dim3(grid), dim3(512), args, LDS_BYTES, stream);
    if (e != hipSuccess) fprintf(stderr, "cooperative launch failed: %s (grid %d)\n", hipGetErrorString(e), grid);
}
```
